# Optimizing an MI355X kernel written in HIP

```python
import math
import jax
import jax.numpy as jnp
from jax import lax
import numpy as np

D_MODEL = 1024
BATCH = 2
SEQ = 16384
DEPTH = 4

N_MEM = 256
BRANCH_W = D_MODEL // 2
N_BRANCH = 3
MIX_W = N_BRANCH * BRANCH_W

FOX_HD = 64
FOX_HEADS = BRANCH_W // FOX_HD
FOX_W = FOX_HEADS * FOX_HD
Q_BLOCK = 128
FOX_FBIAS_OFFSET = 3.0

S5_W = BRANCH_W
S5_GROUP = 16
S5_GROUPS = S5_W // S5_GROUP
S5_STATE = 64

HG_DK = 128
HG_DV = 128
HG_HEADS = BRANCH_W // HG_DV
HG_W = HG_HEADS * HG_DV
HG_CHUNK = 64

X_HEADS = 4
X_HD = D_MODEL // X_HEADS

D_FF = ((8 * D_MODEL + 3 * 256 - 1) // (3 * 256)) * 256

IN_SIZES = (FOX_W, FOX_W, FOX_W, FOX_HEADS, S5_W, HG_HEADS * HG_DK, HG_HEADS * HG_DK, HG_W, HG_W, N_BRANCH * D_MODEL)
IN_COLS = sum(IN_SIZES)
EPS = 1e-6

kernel_name = 'hybrid_fox_s5_hgrn2_gated_trunk'


def rmsnorm(x, g):
    xf = x.astype(jnp.float32)
    y = xf * lax.rsqrt(jnp.mean(xf * xf, axis=-1, keepdims=True) + EPS)
    return (y * g.astype(jnp.float32)).astype(x.dtype)


def _split_points(sizes):
    pts, acc = [], 0
    for s in sizes[:-1]:
        acc += s
        pts.append(acc)
    return pts


def fox_attention(q, k, v, log_f):
    bsz, seq, n_h, hd = q.shape
    n_blk = seq // Q_BLOCK
    c = jnp.cumsum(log_f, axis=1)
    c_keys = c.transpose(0, 2, 1)[:, :, None, :]
    q_blocks = q.reshape(bsz, n_blk, Q_BLOCK, n_h, hd).transpose(1, 0, 2, 3, 4)
    c_blocks = c.reshape(bsz, n_blk, Q_BLOCK, n_h).transpose(1, 0, 3, 2)
    k_pos = jnp.arange(seq)
    scale = hd ** -0.5

    def block(args):
        qi, ci, bi = args
        s = jnp.einsum('bqhd,bkhd->bhqk', qi, k, preferred_element_type=jnp.float32) * scale
        s = s + ci[..., None] - c_keys
        q_pos = bi * Q_BLOCK + jnp.arange(Q_BLOCK)
        s = jnp.where(k_pos[None, :] <= q_pos[:, None], s, -jnp.inf)
        p = jax.nn.softmax(s, axis=-1).astype(v.dtype)
        return jnp.einsum('bhqk,bkhd->bqhd', p, v)

    out = lax.map(block, (q_blocks, c_blocks, jnp.arange(n_blk)))
    return out.transpose(1, 0, 2, 3, 4).reshape(bsz, seq, n_h, hd)


def _complex_linear_combine(e1, e2):
    a1r, a1i, b1r, b1i = e1
    a2r, a2i, b2r, b2i = e2
    return (a1r * a2r - a1i * a2i,
            a1r * a2i + a1i * a2r,
            a2r * b1r - a2i * b1i + b2r,
            a2r * b1i + a2i * b1r + b2i)


def s5_mixer(u, a_re, a_im, b_re, b_im, c_re, c_im, d_skip, log_dt, w_glu, b_glu):
    bsz, seq, _ = u.shape
    f32 = jnp.float32
    uf = u.astype(f32)
    ug = uf.reshape(bsz, seq, S5_GROUPS, S5_GROUP)
    dt = jnp.exp(log_dt.astype(f32))[:, None]
    ar, ai = a_re.astype(f32), a_im.astype(f32)
    mag = jnp.exp(dt * ar)
    abar_r, abar_i = mag * jnp.cos(dt * ai), mag * jnp.sin(dt * ai)
    inv_den = 1.0 / (ar * ar + ai * ai)
    nr, ni = abar_r - 1.0, abar_i
    coef_r = (nr * ar + ni * ai) * inv_den
    coef_i = (ni * ar - nr * ai) * inv_den
    br, bi = b_re.astype(f32), b_im.astype(f32)
    bbar_r = coef_r[..., None] * br - coef_i[..., None] * bi
    bbar_i = coef_r[..., None] * bi + coef_i[..., None] * br
    drive_r = jnp.einsum('bsgh,gph->bsgp', ug, bbar_r)
    drive_i = jnp.einsum('bsgh,gph->bsgp', ug, bbar_i)
    a_shape = (1, seq, S5_GROUPS, S5_STATE)
    elems = (jnp.broadcast_to(abar_r, a_shape), jnp.broadcast_to(abar_i, a_shape), drive_r, drive_i)
    _, _, h_r, h_i = lax.associative_scan(_complex_linear_combine, elems, axis=1)
    y = (jnp.einsum('bsgp,ghp->bsgh', h_r, c_re.astype(f32))
         - jnp.einsum('bsgp,ghp->bsgh', h_i, c_im.astype(f32)))
    y = y.reshape(bsz, seq, S5_W) + d_skip.astype(f32) * uf
    z = jax.nn.gelu(y)
    out = z * jax.nn.sigmoid(z @ w_glu.astype(f32) + b_glu.astype(f32))
    return out.astype(u.dtype)


def hgrn2_mixer(q, f_logit, i_in, g_out, lb, o_gain):
    bsz, seq = q.shape[0], q.shape[1]
    f32 = jnp.float32
    n_chunks = seq // HG_CHUNK
    z = f_logit.astype(f32)
    log_f = jnp.logaddexp(jnp.log(lb), jnp.log1p(-lb) + jax.nn.log_sigmoid(z))
    key = (1.0 - lb) * jax.nn.sigmoid(-z)
    qf = jax.nn.silu(q.astype(f32))
    vf = i_in.astype(f32)

    def chunks(t):
        return t.reshape(bsz, n_chunks, HG_CHUNK, HG_HEADS, t.shape[-1]).transpose(1, 0, 3, 2, 4)

    causal = jnp.tril(jnp.ones((HG_CHUNK, HG_CHUNK), dtype=bool))[None, None, :, :, None]

    def step(state, xs):
        qc, kc, vc, lfc = xs
        b = jnp.cumsum(lfc, axis=2)
        o_inter = jnp.einsum('bhtk,bhkv->bhtv', qc * jnp.exp(b), state)
        rel = jnp.where(causal, b[:, :, :, None, :] - b[:, :, None, :, :], -jnp.inf)
        scores = jnp.einsum('bhtsk,bhsk->bhts', qc[:, :, :, None, :] * jnp.exp(rel), kc)
        o_intra = jnp.einsum('bhts,bhsv->bhtv', scores, vc)
        b_last = b[:, :, -1:, :]
        new_state = (jnp.exp(b_last[:, :, 0, :])[..., None] * state
                     + jnp.einsum('bhsk,bhsv->bhkv', kc * jnp.exp(b_last - b), vc))
        return new_state, o_inter + o_intra

    init = jnp.zeros((bsz, HG_HEADS, HG_DK, HG_DV), f32)
    _, o = lax.scan(step, init, (chunks(qf), chunks(key), chunks(vf), chunks(log_f)))
    o = o.transpose(1, 0, 3, 2, 4).reshape(bsz, seq, HG_HEADS, HG_DV)
    o = rmsnorm(o, o_gain) * jax.nn.silu(g_out.astype(f32))
    return o.reshape(bsz, seq, HG_W).astype(q.dtype)


def cross_attention(h, m, wq, wk, wv, wo, gq, gk):
    bsz, seq, _ = h.shape
    n_mem = m.shape[1]
    q = rmsnorm((h @ wq).reshape(bsz, seq, X_HEADS, X_HD), gq)
    k = rmsnorm((m @ wk).reshape(bsz, n_mem, X_HEADS, X_HD), gk)
    v = (m @ wv).reshape(bsz, n_mem, X_HEADS, X_HD)
    s = jnp.einsum('bshd,bmhd->bhsm', q, k, preferred_element_type=jnp.float32) * (X_HD ** -0.5)
    p = jax.nn.softmax(s, axis=-1).astype(v.dtype)
    o = jnp.einsum('bhsm,bmhd->bshd', p, v).reshape(bsz, seq, X_HEADS * X_HD)
    return o @ wo


def swiglu(h, w_gu, w_d):
    a, b = jnp.split(h @ w_gu, 2, axis=-1)
    return (jax.nn.silu(a) * b) @ w_d


def setup_inputs(seed: int = 0) -> dict:
    key = jax.random.key(seed)
    keys = jax.random.split(key, 40)
    counter = [0]
    f32 = jnp.float32

    def nxt():
        k = keys[counter[0]]
        counter[0] += 1
        return k

    def nrm(shape, scale):
        return jax.random.normal(nxt(), shape, f32) * scale

    def gain(shape):
        return 1.0 + nrm(shape, 0.02)

    L, D = DEPTH, D_MODEL
    G, P, GS = S5_GROUPS, S5_STATE, S5_GROUP
    return {
        'x': nrm((BATCH, SEQ, D), 1.0),
        'mem': nrm((BATCH, N_MEM, D), 1.0),
        'norm_mix': gain((L, D)),
        'w_in': nrm((L, D, IN_COLS), D ** -0.5),
        'fox_fbias': FOX_FBIAS_OFFSET + nrm((L, FOX_HEADS), 0.5),
        'fox_qnorm': gain((L, FOX_HD)),
        'fox_knorm': gain((L, FOX_HD)),
        's5_a_re': -0.5 + nrm((L, G, P), 0.01),
        's5_a_im': math.pi * jnp.arange(P, dtype=f32)[None, None, :] + nrm((L, G, P), 0.01),
        's5_b_re': nrm((L, G, P, GS), (2 * GS) ** -0.5),
        's5_b_im': nrm((L, G, P, GS), (2 * GS) ** -0.5),
        's5_c_re': nrm((L, G, GS, P), (2 * P) ** -0.5),
        's5_c_im': nrm((L, G, GS, P), (2 * P) ** -0.5),
        's5_d': nrm((L, S5_W), 1.0),
        's5_log_dt': jax.random.uniform(nxt(), (L, G), f32, math.log(1e-3), math.log(1e-1)),
        's5_w_glu': nrm((L, S5_W, S5_W), S5_W ** -0.5),
        's5_b_glu': nrm((L, S5_W), 0.01),
        'hg_lb': nrm((L, HG_HEADS * HG_DK), 0.1),
        'hg_onorm': gain((L, HG_DV)),
        'w_branch': nrm((L, MIX_W, D), BRANCH_W ** -0.5),
        'w_out': nrm((L, D, D), D ** -0.5),
        'norm_x': gain((L, D)),
        'norm_mem': gain((L, D)),
        'xq': nrm((L, D, D), D ** -0.5),
        'xk': nrm((L, D, D), D ** -0.5),
        'xv': nrm((L, D, D), D ** -0.5),
        'xo': nrm((L, D, D), D ** -0.5),
        'x_qnorm': gain((L, X_HD)),
        'x_knorm': gain((L, X_HD)),
        'norm_ffn': gain((L, D)),
        'w_gate_up': nrm((L, D, 2 * D_FF), D ** -0.5),
        'w_down': nrm((L, D_FF, D), D_FF ** -0.5),
    }


def reference(x, mem, norm_mix, w_in, fox_fbias, fox_qnorm, fox_knorm, s5_a_re, s5_a_im,
              s5_b_re, s5_b_im, s5_c_re, s5_c_im, s5_d, s5_log_dt, s5_w_glu, s5_b_glu,
              hg_lb, hg_onorm, w_branch, w_out, norm_x, norm_mem, xq, xk, xv, xo,
              x_qnorm, x_knorm, norm_ffn, w_gate_up, w_down):
    bsz, seq, _ = x.shape
    split_pts = _split_points(IN_SIZES)
    lb_all = jnp.cumsum(jax.nn.softmax(hg_lb.astype(jnp.float32), axis=0), axis=0)
    lb_all = lb_all - lb_all[0:1]
    for l in range(DEPTH):
        h = rmsnorm(x, norm_mix[l])
        proj = h @ w_in[l]
        fq, fk, fv, ff, su, hq, hf, hi, hg, gl = jnp.split(proj, split_pts, axis=-1)
        q = rmsnorm(fq.reshape(bsz, seq, FOX_HEADS, FOX_HD), fox_qnorm[l])
        k = rmsnorm(fk.reshape(bsz, seq, FOX_HEADS, FOX_HD), fox_knorm[l])
        v = fv.reshape(bsz, seq, FOX_HEADS, FOX_HD)
        log_f = jax.nn.log_sigmoid((ff + fox_fbias[l]).astype(jnp.float32))
        y_fox = fox_attention(q, k, v, log_f).reshape(bsz, seq, FOX_W)
        y_s5 = s5_mixer(su, s5_a_re[l], s5_a_im[l], s5_b_re[l], s5_b_im[l], s5_c_re[l], s5_c_im[l],
                        s5_d[l], s5_log_dt[l], s5_w_glu[l], s5_b_glu[l])
        y_hg = hgrn2_mixer(hq.reshape(bsz, seq, HG_HEADS, HG_DK), hf.reshape(bsz, seq, HG_HEADS, HG_DK),
                           hi.reshape(bsz, seq, HG_HEADS, HG_DV), hg.reshape(bsz, seq, HG_HEADS, HG_DV),
                           lb_all[l].reshape(HG_HEADS, HG_DK), hg_onorm[l])
        gates = jax.nn.sigmoid(gl).reshape(bsz, seq, N_BRANCH, D_MODEL)
        wb = w_branch[l]
        merged = (gates[:, :, 0] * (y_fox @ wb[:BRANCH_W])
                  + gates[:, :, 1] * (y_s5 @ wb[BRANCH_W:2 * BRANCH_W])
                  + gates[:, :, 2] * (y_hg @ wb[2 * BRANCH_W:]))
        x = x + merged @ w_out[l]
        x = x + cross_attention(rmsnorm(x, norm_x[l]), rmsnorm(mem, norm_mem[l]),
                                xq[l], xk[l], xv[l], xo[l], x_qnorm[l], x_knorm[l])
        x = x + swiglu(rmsnorm(x, norm_ffn[l]), w_gate_up[l], w_down[l])
    return x
```

```cpp
#include <hip/hip_runtime.h>
#include <hip/hip_cooperative_groups.h>
#include <cstdio>
#include <cstdint>
namespace cg = cooperative_groups;

#ifndef MK_MULTI
#define MK_MULTI 0
#endif

typedef unsigned short bf16_t;
typedef short bf16x8 __attribute__((ext_vector_type(8)));
typedef short bf16x4 __attribute__((ext_vector_type(4)));
typedef float f32x4 __attribute__((ext_vector_type(4)));
typedef float f32x2 __attribute__((ext_vector_type(2)));
typedef __bf16 hbf2 __attribute__((ext_vector_type(2)));
typedef unsigned u32x4 __attribute__((ext_vector_type(4)));
typedef unsigned u32x2 __attribute__((ext_vector_type(2)));

#define DI __device__ __forceinline__
#define MFMA16(a, b, c) __builtin_amdgcn_mfma_f32_16x16x32_bf16((a), (b), (c), 0, 0, 0)

constexpr int T_ = 32768, S_ = 16384, D_ = 1024, NL = 4;
constexpr int INC = 7176, DFF = 2816;
constexpr float LOG2E = 1.4426950408889634f;
constexpr float EPS = 1e-6f;
constexpr int NPH = 15;

constexpr size_t O_WP = 0;
constexpr size_t O_WG = O_WP + 4096ull * 1024 * 2;
constexpr size_t O_WBR = O_WG + 3072ull * 1024 * 2;
constexpr size_t O_WOUT = O_WBR + 3ull * 1024 * 512 * 2;
constexpr size_t O_WXQ = O_WOUT + 1024ull * 1024 * 2;
constexpr size_t O_WXK = O_WXQ + 1024ull * 1024 * 2;
constexpr size_t O_WXV = O_WXK + 1024ull * 1024 * 2;
constexpr size_t O_WXO = O_WXV + 1024ull * 1024 * 2;
constexpr size_t O_WGU = O_WXO + 1024ull * 1024 * 2;
constexpr size_t O_WD = O_WGU + 5632ull * 1024 * 2;
constexpr size_t O_WGLU = O_WD + 1024ull * 2816 * 2;
constexpr size_t O_HB = O_WGLU + 512ull * 512 * 2;
constexpr size_t O_QK = O_HB + (size_t)T_ * 1024 * 2;
constexpr size_t O_SBUF = O_QK + (size_t)T_ * 4096 * 2;
constexpr size_t O_DCY = O_SBUF + 2048ull * 128 * 128 * 2;
constexpr size_t O_LOGF = O_DCY + 2048ull * 128 * 4;
constexpr size_t O_CUM = O_LOGF + (size_t)T_ * 8 * 4;
constexpr size_t O_S5E = O_CUM + (size_t)T_ * 8 * 4;
constexpr size_t O_MEMN = O_S5E + 2ull * 32 * 128 * 64 * 8;
constexpr size_t O_KXR = O_MEMN + 512ull * 1024 * 2;
constexpr size_t O_KXN = O_KXR + 512ull * 1024 * 4;
constexpr size_t O_VXT = O_KXN + 512ull * 1024 * 2;
constexpr size_t O_S5T = O_VXT + 512ull * 1024 * 2;
constexpr size_t O_YF = O_S5T + 32ull * 64 * 36 * 4;
constexpr size_t O_BAR = O_YF + (size_t)T_ * 512 * 2;
constexpr size_t O_GS = O_BAR + 256;
constexpr size_t O_END = O_GS + 256ull * 512 * 256;

struct Params {
  const float *x, *mem, *norm_mix, *w_in, *fox_fbias, *fox_qnorm, *fox_knorm, *s5_a_re, *s5_a_im, *s5_b_re, *s5_b_im,
      *s5_c_re, *s5_c_im, *s5_d, *s5_log_dt, *s5_w_glu, *s5_b_glu, *hg_lb, *hg_onorm, *w_branch, *w_out, *norm_x,
      *norm_mem, *xq, *xk, *xv, *xo, *x_qnorm, *x_knorm, *norm_ffn, *w_gate_up, *w_down;
  float* out;
  unsigned char* ws;
};

DI unsigned pk2(float a, float b) {
  f32x2 v = {a, b};
  hbf2 r = __builtin_convertvector(v, hbf2);
  return __builtin_bit_cast(unsigned, r);
}
DI bf16_t f2bf(float a) { return (bf16_t)(pk2(a, 0.f) & 0xffffu); }
DI float bf2f(bf16_t v) { return __uint_as_float((unsigned)v << 16); }
DI float bflo(unsigned u) { return __uint_as_float(u << 16); }
DI float bfhi(unsigned u) { return __uint_as_float(u & 0xffff0000u); }
DI float wave_sum(float v) {
  v += __shfl_xor(v, 32, 64); v += __shfl_xor(v, 16, 64); v += __shfl_xor(v, 8, 64);
  v += __shfl_xor(v, 4, 64); v += __shfl_xor(v, 2, 64); v += __shfl_xor(v, 1, 64);
  return v;
}
DI float sigmoidf_(float x) { return __builtin_amdgcn_rcpf(1.f + __expf(-x)); }
DI float ex2(float x) { return __builtin_amdgcn_exp2f(x); }
DI f32x4 zero4() { return (f32x4){0.f, 0.f, 0.f, 0.f}; }
DI void store_bf4(bf16_t* p, f32x4 v) { u32x2 w; w.x = pk2(v[0], v[1]); w.y = pk2(v[2], v[3]); *(u32x2*)p = w; }
DI bf16x8 pack8(f32x4 a, f32x4 b) {
  u32x4 w; w.x = pk2(a[0], a[1]); w.y = pk2(a[2], a[3]); w.z = pk2(b[0], b[1]); w.w = pk2(b[2], b[3]);
  return __builtin_bit_cast(bf16x8, w);
}
DI bf16x8 cat4(bf16x4 lo, bf16x4 hi) { return __builtin_shufflevector(lo, hi, 0, 1, 2, 3, 4, 5, 6, 7); }

constexpr int LDT = 72;
template <int NI>
DI void gemm_core(const bf16_t* __restrict__ A, int lda, const bf16_t* __restrict__ Bt, int ldb, int K,
                  f32x4 (&acc)[4][NI], unsigned char* smem, int tid) {
  constexpr int BN = 32 * NI;
  constexpr int NB = BN / 32;
  bf16_t* sA = (bf16_t*)smem;
  bf16_t* sB = sA + 2 * 128 * LDT;
  const int lane = tid & 63, wave = tid >> 6, wr = wave >> 1, wc = wave & 1, fr = lane & 15, fq = lane >> 4;
  const int lrow = tid >> 3, lkc = (tid & 7) * 8;
  u32x4 ra[4], rb[NB];
  const int nk = K >> 6;
  const bf16_t* ga = A + (size_t)lrow * lda + lkc;
  const bf16_t* gb = Bt + (size_t)lrow * ldb + lkc;
#pragma unroll
  for (int i = 0; i < 4; ++i) ra[i] = *(const u32x4*)(ga + (size_t)(32 * i) * lda);
#pragma unroll
  for (int i = 0; i < NB; ++i) rb[i] = *(const u32x4*)(gb + (size_t)(32 * i) * ldb);
#pragma unroll
  for (int i = 0; i < 4; ++i) *(u32x4*)(sA + (lrow + 32 * i) * LDT + lkc) = ra[i];
#pragma unroll
  for (int i = 0; i < NB; ++i) *(u32x4*)(sB + (lrow + 32 * i) * LDT + lkc) = rb[i];
  __syncthreads();
  for (int kt = 0; kt < nk; ++kt) {
    const int buf = kt & 1;
    if (kt + 1 < nk) {
#pragma unroll
      for (int i = 0; i < 4; ++i) ra[i] = *(const u32x4*)(ga + (size_t)(32 * i) * lda + (kt + 1) * 64);
#pragma unroll
      for (int i = 0; i < NB; ++i) rb[i] = *(const u32x4*)(gb + (size_t)(32 * i) * ldb + (kt + 1) * 64);
    }
    const bf16_t* pa = sA + buf * 128 * LDT + (wr * 64 + fr) * LDT + fq * 8;
    const bf16_t* pb = sB + buf * BN * LDT + (wc * 16 * NI + fr) * LDT + fq * 8;
#pragma unroll
    for (int kk = 0; kk < 2; ++kk) {
      bf16x8 af[4], bfr[NI];
#pragma unroll
      for (int i = 0; i < 4; ++i) af[i] = *(const bf16x8*)(pa + i * 16 * LDT + kk * 32);
#pragma unroll
      for (int i = 0; i < NI; ++i) bfr[i] = *(const bf16x8*)(pb + i * 16 * LDT + kk * 32);
#pragma unroll
      for (int mi = 0; mi < 4; ++mi)
#pragma unroll
        for (int ni = 0; ni < NI; ++ni) acc[mi][ni] = MFMA16(bfr[ni], af[mi], acc[mi][ni]);
    }
    if (kt + 1 < nk) {
      const int nb = buf ^ 1;
#pragma unroll
      for (int i = 0; i < 4; ++i) *(u32x4*)(sA + nb * 128 * LDT + (lrow + 32 * i) * LDT + lkc) = ra[i];
#pragma unroll
      for (int i = 0; i < NB; ++i) *(u32x4*)(sB + nb * BN * LDT + (lrow + 32 * i) * LDT + lkc) = rb[i];
    }
    __syncthreads();
  }
}
DI void gemm_core8(const bf16_t* __restrict__ A, int lda, const bf16_t* __restrict__ Bt, int ldb, int K,
                   f32x4 (&acc)[4][8], unsigned char* smem, int t8) {
  bf16_t* sA = (bf16_t*)smem;
  bf16_t* sB = sA + 2 * 256 * LDT;
  const int lane = t8 & 63, wave = t8 >> 6, wr = wave >> 1, wc = wave & 1, fr = lane & 15, fq = lane >> 4;
  const int lrow = t8 >> 3, lkc = (t8 & 7) * 8;
  u32x4 ra[4], rb[4];
  const int nk = K >> 6;
  const bf16_t* ga = A + (size_t)lrow * lda + lkc;
  const bf16_t* gb = Bt + (size_t)lrow * ldb + lkc;
#pragma unroll
  for (int i = 0; i < 4; ++i) { ra[i] = *(const u32x4*)(ga + (size_t)(64 * i) * lda); rb[i] = *(const u32x4*)(gb + (size_t)(64 * i) * ldb); }
#pragma unroll
  for (int i = 0; i < 4; ++i) { *(u32x4*)(sA + (lrow + 64 * i) * LDT + lkc) = ra[i]; *(u32x4*)(sB + (lrow + 64 * i) * LDT + lkc) = rb[i]; }
  __syncthreads();
  for (int kt = 0; kt < nk; ++kt) {
    const int buf = kt & 1;
    if (kt + 1 < nk) {
#pragma unroll
      for (int i = 0; i < 4; ++i) { ra[i] = *(const u32x4*)(ga + (size_t)(64 * i) * lda + (kt + 1) * 64); rb[i] = *(const u32x4*)(gb + (size_t)(64 * i) * ldb + (kt + 1) * 64); }
    }
    const bf16_t* pa = sA + buf * 256 * LDT + (wr * 64 + fr) * LDT + fq * 8;
    const bf16_t* pb = sB + buf * 256 * LDT + (wc * 128 + fr) * LDT + fq * 8;
#pragma unroll
    for (int kk = 0; kk < 2; ++kk) {
      bf16x8 af[4];
#pragma unroll
      for (int i = 0; i < 4; ++i) af[i] = *(const bf16x8*)(pa + i * 16 * LDT + kk * 32);
#pragma unroll
      for (int nh = 0; nh < 2; ++nh) {
        bf16x8 bfr[4];
#pragma unroll
        for (int i = 0; i < 4; ++i) bfr[i] = *(const bf16x8*)(pb + (nh * 4 + i) * 16 * LDT + kk * 32);
#pragma unroll
        for (int mi = 0; mi < 4; ++mi)
#pragma unroll
          for (int ni = 0; ni < 4; ++ni) acc[mi][nh * 4 + ni] = MFMA16(bfr[ni], af[mi], acc[mi][nh * 4 + ni]);
      }
    }
    if (kt + 1 < nk) {
      const int nb = buf ^ 1;
#pragma unroll
      for (int i = 0; i < 4; ++i) { *(u32x4*)(sA + nb * 256 * LDT + (lrow + 64 * i) * LDT + lkc) = ra[i]; *(u32x4*)(sB + nb * 256 * LDT + (lrow + 64 * i) * LDT + lkc) = rb[i]; }
    }
    __syncthreads();
  }
}
DI void gemm_core8b(const bf16_t* __restrict__ A, int lda, const bf16_t* __restrict__ Bt, int ldb, int K,
                    f32x4 (&acc)[4][4], unsigned char* smem, int t8) {
  bf16_t* sA = (bf16_t*)smem;
  bf16_t* sB = sA + 2 * 256 * LDT;
  const int lane = t8 & 63, wave = t8 >> 6, wr = wave >> 1, wc = wave & 1, fr = lane & 15, fq = lane >> 4;
  const int lrow = t8 >> 3, lkc = (t8 & 7) * 8;
  u32x4 ra[4], rb[2];
  const int nk = K >> 6;
  const bf16_t* ga = A + (size_t)lrow * lda + lkc;
  const bf16_t* gb = Bt + (size_t)lrow * ldb + lkc;
#pragma unroll
  for (int i = 0; i < 4; ++i) ra[i] = *(const u32x4*)(ga + (size_t)(64 * i) * lda);
#pragma unroll
  for (int i = 0; i < 2; ++i) rb[i] = *(const u32x4*)(gb + (size_t)(64 * i) * ldb);
#pragma unroll
  for (int i = 0; i < 4; ++i) *(u32x4*)(sA + (lrow + 64 * i) * LDT + lkc) = ra[i];
#pragma unroll
  for (int i = 0; i < 2; ++i) *(u32x4*)(sB + (lrow + 64 * i) * LDT + lkc) = rb[i];
  __syncthreads();
  for (int kt = 0; kt < nk; ++kt) {
    const int buf = kt & 1;
    if (kt + 1 < nk) {
#pragma unroll
      for (int i = 0; i < 4; ++i) ra[i] = *(const u32x4*)(ga + (size_t)(64 * i) * lda + (kt + 1) * 64);
#pragma unroll
      for (int i = 0; i < 2; ++i) rb[i] = *(const u32x4*)(gb + (size_t)(64 * i) * ldb + (kt + 1) * 64);
    }
    const bf16_t* pa = sA + buf * 256 * LDT + (wr * 64 + fr) * LDT + fq * 8;
    const bf16_t* pb = sB + buf * 128 * LDT + (wc * 64 + fr) * LDT + fq * 8;
#pragma unroll
    for (int kk = 0; kk < 2; ++kk) {
      bf16x8 af[4];
#pragma unroll
      for (int i = 0; i < 4; ++i) af[i] = *(const bf16x8*)(pa + i * 16 * LDT + kk * 32);
#pragma unroll
      for (int nh = 0; nh < 2; ++nh) {
        bf16x8 bfr[2];
#pragma unroll
        for (int i = 0; i < 2; ++i) bfr[i] = *(const bf16x8*)(pb + (nh * 2 + i) * 16 * LDT + kk * 32);
#pragma unroll
        for (int mi = 0; mi < 4; ++mi)
#pragma unroll
          for (int ni = 0; ni < 2; ++ni) acc[mi][nh * 2 + ni] = MFMA16(bfr[ni], af[mi], acc[mi][nh * 2 + ni]);
      }
    }
    if (kt + 1 < nk) {
      const int nb = buf ^ 1;
#pragma unroll
      for (int i = 0; i < 4; ++i) *(u32x4*)(sA + nb * 256 * LDT + (lrow + 64 * i) * LDT + lkc) = ra[i];
#pragma unroll
      for (int i = 0; i < 2; ++i) *(u32x4*)(sB + nb * 128 * LDT + (lrow + 64 * i) * LDT + lkc) = rb[i];
    }
    __syncthreads();
  }
}
DI int lds_byte8(int r, int c) { const int st = (r >> 4) * 2 + (c >> 5), rr = r & 15, cc = c & 31, ob = rr * 64 + cc * 2; return st * 1024 + (ob ^ (((ob >> 9) & 1) << 5)); }
DI void stage_rc8(int b, int& R, int& C) { const int st = b / 1024, sb = b % 1024, swz = sb ^ (((sb >> 9) & 1) << 5); R = (st >> 1) * 16 + swz / 64; C = (st & 1) * 32 + (swz % 64) / 2; }
DI void gemm8p(const bf16_t* __restrict__ A, int lda, const bf16_t* __restrict__ Bt, int ldb, int K,
               f32x4 (&acc)[2][2][4][2], unsigned char* smem, int t8, const bool pre = false) {
  const int wid = t8 >> 6, lane = t8 & 63, wr = wid >> 2, wc = wid & 3, fr = lane & 15, fq = lane >> 4;
  const int frag = (fr * 64 + fq * 16) ^ ((fr >> 3) << 5);
  const char* pA = (const char*)smem + wr * 8192 + frag;
  const char* pB = (const char*)smem + 4 * 16384 + wc * 4096 + frag;
  const int swz = ((lane * 16) ^ ((lane >> 5) << 5));
  const int R0 = (wid >> 1) * 16 + (swz >> 6), C0 = (wid & 1) * 32 + ((swz & 63) >> 1);
  unsigned offA = (unsigned)(R0 * lda + C0), offB = (unsigned)(R0 * ldb + C0);
  char* pS = (char*)smem + t8 * 16;
#define G8_STAGE_A(bh, half, kt) do { asm volatile("" : "+v"(offA)); \
    _Pragma("unroll") for (int _i = 0; _i < 2; ++_i) \
      __builtin_amdgcn_global_load_lds((const unsigned*)(A + (offA + (unsigned)(((half) * 128 + _i * 64) * lda + (kt) * 64))), \
        (unsigned*)(pS + (bh) * 16384 + _i * 8192), 16, 0, 0); } while (0)
#define G8_STAGE_B(bh, half, kt) do { asm volatile("" : "+v"(offB)); \
    _Pragma("unroll") for (int _i = 0; _i < 2; ++_i) \
      __builtin_amdgcn_global_load_lds((const unsigned*)(Bt + (offB + (unsigned)(((half) * 128 + _i * 64) * ldb + (kt) * 64))), \
        (unsigned*)(pS + (4 + (bh)) * 16384 + _i * 8192), 16, 0, 0); } while (0)
#define G8_LDA(dst, bh) _Pragma("unroll") for (int m = 0; m < 4; ++m) _Pragma("unroll") for (int k = 0; k < 2; ++k) \
    dst[m][k] = *reinterpret_cast<const bf16x8*>(pA + (bh) * 16384 + (m * 2 + k) * 1024)
#define G8_LDB(dst, bh) _Pragma("unroll") for (int n = 0; n < 2; ++n) _Pragma("unroll") for (int k = 0; k < 2; ++k) \
    dst[n][k] = *reinterpret_cast<const bf16x8*>(pB + (bh) * 16384 + (n * 2 + k) * 1024)
#define G8_MMA(ai, bj, At_, Bt_) do { __builtin_amdgcn_s_setprio(1); \
    _Pragma("unroll") for (int m = 0; m < 4; ++m) _Pragma("unroll") for (int n = 0; n < 2; ++n) _Pragma("unroll") for (int k = 0; k < 2; ++k) \
      acc[ai][bj][m][n] = MFMA16(Bt_[n][k], At_[m][k], acc[ai][bj][m][n]); \
    __builtin_amdgcn_s_setprio(0); } while (0)
#define G8_WAIT_V(n) asm volatile("s_waitcnt vmcnt(" #n ")" ::: "memory")
#define G8_WAIT_L(n) asm volatile("s_waitcnt lgkmcnt(" #n ")" ::: "memory")
#define G8_BAR __builtin_amdgcn_s_barrier()
#define G8_SCHED __builtin_amdgcn_sched_barrier(0)
  bf16x8 At[4][2], B0[2][2], B1[2][2];
  const int nt = K / 64;
  if (!pre) {
    G8_WAIT_V(0);
    G8_STAGE_B(0, 0, 0); G8_STAGE_A(0, 0, 0);
    G8_STAGE_B(1, 1, 0); G8_STAGE_A(1, 1, 0);
    if (wr == 1) G8_BAR;
    G8_WAIT_V(4); G8_BAR;
  } else {
    if (wr == 1) G8_BAR;
    G8_WAIT_V(0); G8_BAR;
  }
  G8_STAGE_B(2, 0, 1); G8_STAGE_A(2, 0, 1); G8_STAGE_B(3, 1, 1);
  G8_WAIT_V(6); G8_BAR;
  for (int t = 0; t < nt - 2; t += 2) {
    G8_LDB(B0, 0); G8_SCHED; G8_LDA(At, 0); G8_STAGE_A(3, 1, t + 1);
    G8_WAIT_L(8); G8_BAR; G8_WAIT_L(0); G8_MMA(0, 0, At, B0); G8_BAR; G8_SCHED;
    G8_LDB(B1, 1); G8_STAGE_B(0, 0, t + 2);
    G8_BAR; G8_WAIT_L(0); G8_MMA(0, 1, At, B1); G8_BAR;
    G8_LDA(At, 1); G8_STAGE_A(0, 0, t + 2);
    G8_BAR; G8_WAIT_L(0); G8_MMA(1, 0, At, B0); G8_BAR; G8_SCHED;
    G8_STAGE_B(1, 1, t + 2);
    G8_WAIT_V(6); G8_BAR; G8_MMA(1, 1, At, B1); G8_BAR;
    G8_LDB(B0, 2); G8_SCHED; G8_LDA(At, 2); G8_STAGE_A(1, 1, t + 2);
    G8_WAIT_L(8); G8_BAR; G8_WAIT_L(0); G8_MMA(0, 0, At, B0); G8_BAR; G8_SCHED;
    G8_LDB(B1, 3); G8_STAGE_B(2, 0, t + 3);
    G8_BAR; G8_WAIT_L(0); G8_MMA(0, 1, At, B1); G8_BAR;
    G8_LDA(At, 3); G8_STAGE_A(2, 0, t + 3);
    G8_BAR; G8_WAIT_L(0); G8_MMA(1, 0, At, B0); G8_BAR; G8_SCHED;
    G8_STAGE_B(3, 1, t + 3);
    G8_WAIT_V(6); G8_BAR; G8_MMA(1, 1, At, B1); G8_BAR;
  }
  { G8_LDB(B0, 0); G8_LDA(At, 0); G8_STAGE_A(3, 1, nt - 1);
    G8_BAR; G8_WAIT_L(0); G8_MMA(0, 0, At, B0); G8_BAR;
    G8_LDB(B1, 1); G8_BAR; G8_WAIT_L(0); G8_MMA(0, 1, At, B1); G8_BAR;
    G8_LDA(At, 1); G8_WAIT_V(4); G8_BAR; G8_WAIT_L(0); G8_MMA(1, 0, At, B0); G8_MMA(1, 1, At, B1); G8_BAR; }
  { G8_LDB(B0, 2); G8_LDA(At, 2); G8_WAIT_V(2); G8_BAR; G8_WAIT_L(0); G8_MMA(0, 0, At, B0); G8_BAR;
    G8_LDB(B1, 3); G8_WAIT_V(0); G8_BAR; G8_WAIT_L(0); G8_MMA(0, 1, At, B1); G8_BAR;
    G8_LDA(At, 3); G8_BAR; G8_WAIT_L(0); G8_MMA(1, 0, At, B0); G8_MMA(1, 1, At, B1); G8_BAR; }
  if (wr == 0) G8_BAR;
}
DI void xcd_tile(int it, int WG, int NWG, int NT, int& mt, int& nt) {
  int L = it;
  if (NWG == 256) L = (it - WG) + (WG & 7) * 32 + (WG >> 3);
  const int g = L / (8 * NT), idx = L - g * (8 * NT);
  mt = g * 8 + (idx & 7); nt = idx >> 3;
}
DI void g8_issue(const bf16_t* __restrict__ A, int lda, const bf16_t* __restrict__ Bt, int ldb, unsigned char* smem, int t8) {
  const int wid = t8 >> 6, lane = t8 & 63;
  const int swz = ((lane * 16) ^ ((lane >> 5) << 5));
  const int R0 = (wid >> 1) * 16 + (swz >> 6), C0 = (wid & 1) * 32 + ((swz & 63) >> 1);
  unsigned offA = (unsigned)(R0 * lda + C0), offB = (unsigned)(R0 * ldb + C0);
  char* pS = (char*)smem + t8 * 16;
  G8_STAGE_B(0, 0, 0); G8_STAGE_A(0, 0, 0);
  G8_STAGE_B(1, 1, 0); G8_STAGE_A(1, 1, 0);
}
DI void zero_acc8p(f32x4 (&acc)[2][2][4][2]) {
#pragma unroll
  for (int a = 0; a < 2; ++a)
#pragma unroll
    for (int b = 0; b < 2; ++b)
#pragma unroll
      for (int m = 0; m < 4; ++m)
#pragma unroll
        for (int n = 0; n < 2; ++n) acc[a][b][m][n] = zero4();
}
DI void zero_acc8(f32x4 (&acc)[4][8]) {
#pragma unroll
  for (int i = 0; i < 4; ++i)
#pragma unroll
    for (int j = 0; j < 8; ++j) acc[i][j] = zero4();
}
template <int NI>
DI void zero_acc(f32x4 (&acc)[4][NI]) {
#pragma unroll
  for (int i = 0; i < 4; ++i)
#pragma unroll
    for (int j = 0; j < NI; ++j) acc[i][j] = zero4();
}

DI int conv_col(int n, int mode, int base) {
  if (mode == 0) return n + base;
  if (mode == 1) return n < 1536 ? n : n + 8;
  const int g = n >> 5, s = (n >> 4) & 1, i = n & 15;
  return s * DFF + g * 16 + i;
}
DI void conv_tile(const float* __restrict__ src, int ld, bf16_t* __restrict__ dst, int Kd, int k0, int n0, int mode, int base,
                  bf16_t* tile, int tid) {
  const int n4 = (tid & 15) * 4, kr = tid >> 4;
  const int col = conv_col(n0 + n4, mode, base);
#pragma unroll
  for (int i = 0; i < 4; ++i) {
    const int k = kr + 16 * i;
    const f32x4 v = *(const f32x4*)(src + (size_t)(k0 + k) * ld + col);
    tile[(n4 + 0) * LDT + k] = f2bf(v[0]);
    tile[(n4 + 1) * LDT + k] = f2bf(v[1]);
    tile[(n4 + 2) * LDT + k] = f2bf(v[2]);
    tile[(n4 + 3) * LDT + k] = f2bf(v[3]);
  }
  __syncthreads();
  const int kc = (tid & 7) * 8, nr = tid >> 3;
#pragma unroll
  for (int i = 0; i < 2; ++i) {
    const int n = nr + 32 * i;
    *(u32x4*)(dst + (size_t)(n0 + n) * Kd + k0 + kc) = *(const u32x4*)(tile + n * LDT + kc);
  }
  __syncthreads();
}

DI void conv_item(const Params& p, int l, int it, bf16_t* tile, int tid) {
  unsigned char* ws = p.ws;
  if (it < 1024) { conv_tile(p.w_in + (size_t)l * D_ * INC, INC, (bf16_t*)(ws + O_WP), 1024, (it & 15) * 64, (it >> 4) * 64, 1, 0, tile, tid); return; }
  it -= 1024;
  if (it < 768) { conv_tile(p.w_in + (size_t)l * D_ * INC, INC, (bf16_t*)(ws + O_WG), 1024, (it & 15) * 64, (it >> 4) * 64, 0, 4104, tile, tid); return; }
  it -= 768;
  if (it < 384) { const int b = it >> 7, r = it & 127;
    conv_tile(p.w_branch + (size_t)l * 1536 * 1024 + (size_t)b * 512 * 1024, 1024, (bf16_t*)(ws + O_WBR) + (size_t)b * 1024 * 512, 512, (r & 7) * 64, (r >> 3) * 64, 0, 0, tile, tid); return; }
  it -= 384;
  if (it < 1280) { const int w = it >> 8, r = it & 255;
    const float* src = (w == 0 ? p.w_out : w == 1 ? p.xq : w == 2 ? p.xk : w == 3 ? p.xv : p.xo) + (size_t)l * 1024 * 1024;
    bf16_t* dst = (bf16_t*)(ws + (w == 0 ? O_WOUT : w == 1 ? O_WXQ : w == 2 ? O_WXK : w == 3 ? O_WXV : O_WXO));
    conv_tile(src, 1024, dst, 1024, (r & 15) * 64, (r >> 4) * 64, 0, 0, tile, tid); return; }
  it -= 1280;
  if (it < 1408) { conv_tile(p.w_gate_up + (size_t)l * 1024 * 5632, 5632, (bf16_t*)(ws + O_WGU), 1024, (it & 15) * 64, (it >> 4) * 64, 2, 0, tile, tid); return; }
  it -= 1408;
  if (it < 704) { const int kt = it % 44, nt = it / 44;
    conv_tile(p.w_down + (size_t)l * DFF * 1024, 1024, (bf16_t*)(ws + O_WD), DFF, kt * 64, nt * 64, 0, 0, tile, tid); return; }
  it -= 704;
  conv_tile(p.s5_w_glu + (size_t)l * 512 * 512, 512, (bf16_t*)(ws + O_WGLU), 512, (it & 7) * 64, (it >> 3) * 64, 0, 0, tile, tid);
}
constexpr int N_CONV = 1024 + 768 + 384 + 1280 + 1408 + 704 + 64;

DI void norm_item(const float* __restrict__ X, const float* __restrict__ gain, bf16_t* __restrict__ Hout, int row0,
                  const float* wfft, float* __restrict__ logf_out, const float* __restrict__ fbias, int tid) {
  const int lane = tid & 63, wave = tid >> 6;
  f32x4 g4[4];
#pragma unroll
  for (int i = 0; i < 4; ++i) g4[i] = *(const f32x4*)(gain + i * 256 + lane * 4);
  for (int rr = 0; rr < 8; ++rr) {
    const int row = row0 + wave * 8 + rr;
    const float* xr = X + (size_t)row * 1024;
    f32x4 v[4];
    float ss = 0.f;
#pragma unroll
    for (int i = 0; i < 4; ++i) {
      v[i] = *(const f32x4*)(xr + i * 256 + lane * 4);
      ss += v[i][0] * v[i][0] + v[i][1] * v[i][1] + v[i][2] * v[i][2] + v[i][3] * v[i][3];
    }
    ss = wave_sum(ss);
    const float rs = rsqrtf(ss * (1.f / 1024.f) + EPS);
#pragma unroll
    for (int i = 0; i < 4; ++i) {
      v[i] = v[i] * rs * g4[i];
      store_bf4(Hout + (size_t)row * 1024 + i * 256 + lane * 4, v[i]);
    }
    if (wfft) {
      float mine = 0.f;
#pragma unroll
      for (int j = 0; j < 8; ++j) {
        float a = 0.f;
#pragma unroll
        for (int i = 0; i < 4; ++i) {
          const f32x4 w = *(const f32x4*)(wfft + j * 1024 + i * 256 + lane * 4);
          a += v[i][0] * w[0] + v[i][1] * w[1] + v[i][2] * w[2] + v[i][3] * w[3];
        }
        a = wave_sum(a);
        mine = (lane == j) ? a : mine;
      }
      if (lane < 8) {
        const float xv = mine + fbias[lane];
        logf_out[(size_t)row * 8 + lane] = fminf(xv, 0.f) - __logf(1.f + __expf(-fabsf(xv)));
      }
    }
  }
}

DI void cumsum_item(const Params& p, int bh, unsigned char* smem, int tid) {
  const float* logf = (const float*)(p.ws + O_LOGF);
  float* cum = (float*)(p.ws + O_CUM);
  float* part = (float*)smem;
  const int b = bh >> 3, h = bh & 7;
  const float* src = logf + ((size_t)b * S_ + tid * 64) * 8 + h;
  float s = 0.f;
  for (int j = 0; j < 64; ++j) s += src[j * 8];
  part[tid] = s;
  __syncthreads();
  float pre = 0.f;
  for (int j = 0; j < tid; ++j) pre += part[j];
  float* dst = cum + (size_t)bh * S_ + tid * 64;
  for (int j = 0; j < 64; ++j) { pre += src[j * 8]; dst[j] = pre * LOG2E; }
  __syncthreads();
}

constexpr int LDK = 72;
DI void fox_item(const Params& p, int fox_l, int idx, unsigned char* smem, int tid) {
  bf16_t* QK = (bf16_t*)(p.ws + O_QK);
  const int bh = idx & 15, qt = 63 - (idx >> 4);
  const int b = bh >> 3, h = bh & 7;
  const int lane = tid & 63, wave = tid >> 6, fr = lane & 15, fq = lane >> 4;
  const float* cum = (const float*)(p.ws + O_CUM) + (size_t)bh * S_;
  const size_t rowbase = (size_t)b * S_;
  const int q0 = qt * 256 + wave * 32;
  bf16_t* sK = (bf16_t*)smem;
  bf16_t* sV = sK + 2 * 64 * LDK;
  float* sC = (float*)(sV + 2 * 64 * LDK);
  int* sF = (int*)(sC + 128);
  float qkb;
  {
    float gq = fabsf(p.fox_qnorm[fox_l * 64 + lane]), gk = fabsf(p.fox_knorm[fox_l * 64 + lane]);
#pragma unroll
    for (int mm = 32; mm >= 1; mm >>= 1) { gq = fmaxf(gq, __shfl_xor(gq, mm, 64)); gk = fmaxf(gk, __shfl_xor(gk, mm, 64)); }
    qkb = 8.f * LOG2E * gq * gk * 1.02f + 40.f;
  }
  bool wdone = false;
  bf16x8 qf[2][2];
  float cq[2];
#pragma unroll
  for (int f = 0; f < 2; ++f) {
    const int q = q0 + f * 16 + fr;
    const bf16_t* qp = QK + (rowbase + q) * 4096 + h * 64;
    qf[f][0] = *(const bf16x8*)(qp + fq * 8);
    qf[f][1] = *(const bf16x8*)(qp + 32 + fq * 8);
    cq[f] = cum[q];
  }
  f32x4 o[4][2];
#pragma unroll
  for (int d = 0; d < 4; ++d) { o[d][0] = zero4(); o[d][1] = zero4(); }
  float m[2] = {-1e30f, -1e30f}, ls[2] = {0.f, 0.f};
  const int ntiles = (qt + 1) * 4;
  const int kkey = tid >> 3, kdc = (tid & 7) * 8;
  const int vkey = tid & 63, vdc = (tid >> 6) * 8;
  const bf16_t* gk = QK + (rowbase + kkey) * 4096 + 512 + h * 64 + kdc;
  const bf16_t* gv = QK + (rowbase + vkey) * 4096 + 1024 + h * 64 + vdc;
  u32x4 rk0[1], rv0[1], rk1[1], rv1[1];
  float rc0 = 0.f, rc1 = 0.f;
  auto gload = [&](int t, u32x4 (&rk)[1], u32x4 (&rv)[1], float& rc) {
    const size_t off = (size_t)t * 64 * 4096;
    rk[0] = *(const u32x4*)(gk + off);
    rv[0] = *(const u32x4*)(gv + off);
    if (tid < 64) rc = cum[t * 64 + tid];
  };
  auto sstore = [&](int buf, const u32x4 (&rk)[1], const u32x4 (&rv)[1], float rc) {
    {
      *(u32x4*)(sK + buf * 64 * LDK + kkey * LDK + kdc) = rk[0];
      bf16_t* vp = sV + buf * 64 * LDK + vdc * LDK + vkey;
      const u32x4 w = rv[0];
      vp[0 * LDK] = (bf16_t)(w.x & 0xffff); vp[1 * LDK] = (bf16_t)(w.x >> 16);
      vp[2 * LDK] = (bf16_t)(w.y & 0xffff); vp[3 * LDK] = (bf16_t)(w.y >> 16);
      vp[4 * LDK] = (bf16_t)(w.z & 0xffff); vp[5 * LDK] = (bf16_t)(w.z >> 16);
      vp[6 * LDK] = (bf16_t)(w.w & 0xffff); vp[7 * LDK] = (bf16_t)(w.w >> 16);
    }
    if (tid < 64) sC[buf * 64 + tid] = rc;
  };
  auto compute = [&](int t, int buf) {
    const int k0 = t * 64;
    if (!wdone && k0 <= q0 + 31) {
      const float cnew = sC[buf * 64 + 63];
      const bool prune = (qkb + cq[0] - cnew < m[0]) && (qkb + cq[1] - cnew < m[1]);
      if (__builtin_amdgcn_ballot_w64(!prune) == 0ull) wdone = true;
    }
    if (!wdone && k0 <= q0 + 31) {
      const bf16_t* bK = sK + buf * 64 * LDK;
      const bf16_t* bV = sV + buf * 64 * LDK;
      const float* bC = sC + buf * 64;
      f32x4 s[4][2];
#pragma unroll
      for (int kf = 0; kf < 4; ++kf) {
        s[kf][0] = (f32x4){cq[0], cq[0], cq[0], cq[0]};
        s[kf][1] = (f32x4){cq[1], cq[1], cq[1], cq[1]};
      }
#pragma unroll
      for (int kk = 0; kk < 2; ++kk)
#pragma unroll
        for (int kf = 0; kf < 4; ++kf) {
          const bf16x8 a = *(const bf16x8*)(bK + (kf * 16 + fr) * LDK + kk * 32 + fq * 8);
          s[kf][0] = MFMA16(a, qf[0][kk], s[kf][0]);
          s[kf][1] = MFMA16(a, qf[1][kk], s[kf][1]);
        }
#pragma unroll
      for (int kf = 0; kf < 4; ++kf) {
        const f32x4 ck = *(const f32x4*)(bC + kf * 16 + fq * 4);
        s[kf][0] -= ck; s[kf][1] -= ck;
      }
      if (k0 + 63 > q0) {
#pragma unroll
        for (int kf = 0; kf < 4; ++kf)
#pragma unroll
          for (int f = 0; f < 2; ++f)
#pragma unroll
            for (int r = 0; r < 4; ++r) {
              const int key = k0 + kf * 16 + fq * 4 + r, q = q0 + f * 16 + fr;
              if (key > q) s[kf][f][r] = -1e30f;
            }
      }
#pragma unroll
      for (int f = 0; f < 2; ++f) {
        float mx = -1e30f;
#pragma unroll
        for (int kf = 0; kf < 4; ++kf)
#pragma unroll
          for (int r = 0; r < 4; ++r) mx = fmaxf(mx, s[kf][f][r]);
        mx = fmaxf(mx, __shfl_xor(mx, 16, 64));
        mx = fmaxf(mx, __shfl_xor(mx, 32, 64));
        const float mn = fmaxf(m[f], mx);
        const float alpha = ex2(m[f] - mn);
        m[f] = mn;
        float ps = 0.f;
#pragma unroll
        for (int kf = 0; kf < 4; ++kf)
#pragma unroll
          for (int r = 0; r < 4; ++r) { const float pv = ex2(s[kf][f][r] - mn); s[kf][f][r] = pv; ps += pv; }
        ls[f] = ls[f] * alpha + ps;
#pragma unroll
        for (int d = 0; d < 4; ++d) o[d][f] *= alpha;
      }
#pragma unroll
      for (int ss = 0; ss < 2; ++ss) {
        const bf16x8 pb0 = pack8(s[2 * ss][0], s[2 * ss + 1][0]);
        const bf16x8 pb1 = pack8(s[2 * ss][1], s[2 * ss + 1][1]);
#pragma unroll
        for (int d = 0; d < 4; ++d) {
          const bf16_t* vp = bV + (d * 16 + fr) * LDK + ss * 32 + fq * 4;
          const bf16x8 a = cat4(*(const bf16x4*)vp, *(const bf16x4*)(vp + 16));
          o[d][0] = MFMA16(a, pb0, o[d][0]);
          o[d][1] = MFMA16(a, pb1, o[d][1]);
        }
      }
    }
  };
  const int T = ntiles;
  gload(T - 1, rk0, rv0, rc0); sstore(0, rk0, rv0, rc0);
  gload(T - 2, rk0, rv0, rc0);
  if (T > 2) gload(T - 3, rk1, rv1, rc1);
  if (tid < 16) sF[tid] = 0;
  __syncthreads();
  int par = 0;
  for (int i = 0; i < T; i += 2) {
    if (i > 0) {
      int alldone = 1;
#pragma unroll
      for (int w = 0; w < 8; ++w) alldone &= sF[par * 8 + w];
      par ^= 1;
      if (alldone) break;
    }
    compute(T - 1 - i, 0);
    sstore(1, rk0, rv0, rc0);
    if (i + 3 < T) gload(T - 4 - i, rk0, rv0, rc0);
    __syncthreads();
    compute(T - 2 - i, 1);
    if (i + 2 < T) sstore(0, rk1, rv1, rc1);
    if (i + 4 < T) gload(T - 5 - i, rk1, rv1, rc1);
    if (lane == 0) sF[par * 8 + wave] = wdone ? 1 : 0;
    __syncthreads();
  }
  __syncthreads();
#pragma unroll
  for (int f = 0; f < 2; ++f) {
    float l = ls[f];
    l += __shfl_xor(l, 16, 64); l += __shfl_xor(l, 32, 64);
    const float inv = 1.f / l;
    const int q = q0 + f * 16 + fr;
    bf16_t* op = (bf16_t*)(p.ws + O_YF) + (rowbase + q) * 512 + h * 64 + fq * 4;
#pragma unroll
    for (int d = 0; d < 4; ++d) store_bf4(op + d * 16, o[d][f] * inv);
  }
}

DI float hg_lb_of(const Params& p, int l, int c) {
  float e[NL], tot = 0.f, part = 0.f;
  float mx = -1e30f;
#pragma unroll
  for (int j = 0; j < NL; ++j) { e[j] = p.hg_lb[j * 512 + c]; mx = fmaxf(mx, e[j]); }
#pragma unroll
  for (int j = 0; j < NL; ++j) { e[j] = __expf(e[j] - mx); tot += e[j]; part += (j >= 1 && j <= l) ? e[j] : 0.f; }
  return part / tot;
}
DI void hg_gate(float z, float lb, float& logf, float& key) {
  const float sg = sigmoidf_(z);
  const float f = lb + (1.f - lb) * sg;
  key = (1.f - lb) * (1.f - sg);
  const float lsg = fminf(z, 0.f) - __logf(1.f + __expf(-fabsf(z)));
  logf = (lb == 0.f) ? lsg : __logf(f);
}
constexpr int LDH = 136;
DI void hg1_item(const Params& p, int l, int ch, unsigned char* smem, int tid) {
  const bf16_t* QK = (const bf16_t*)(p.ws + O_QK);
  bf16_t* SB = (bf16_t*)(p.ws + O_SBUF) + (size_t)ch * 16384;
  float* DC = (float*)(p.ws + O_DCY) + (size_t)ch * 128;
  const int bhh = ch >> 8, c = ch & 255, b = bhh >> 2, h = bhh & 3;
  const size_t row0 = (size_t)b * S_ + c * 64;
  bf16_t* kT = (bf16_t*)smem;
  bf16_t* vT = kT + 128 * LDK;
  float* sums = (float*)(vT + 128 * LDK);
  const int k = tid & 127, th = tid >> 7;
  const float lb = hg_lb_of(p, l, h * 128 + k);
  float lf[32], ky[32];
  float loc = 0.f;
  const bf16_t* zf = QK + (row0 + th * 32) * 4096 + 5 * 512 + h * 128 + k;
#pragma unroll
  for (int j = 0; j < 32; ++j) {
    hg_gate(bf2f(zf[(size_t)j * 4096]), lb, lf[j], ky[j]);
    loc += lf[j];
  }
  sums[th * 128 + k] = loc;
  {
    const int s = tid & 63, vc = (tid >> 6) * 8;
#pragma unroll
    for (int i = 0; i < 4; ++i) {
      const u32x4 w = *(const u32x4*)(QK + (row0 + s) * 4096 + 6 * 512 + h * 128 + vc + 32 * i);
      bf16_t* vp = vT + (vc + 32 * i) * LDK + s;
      vp[0 * LDK] = (bf16_t)(w.x & 0xffff); vp[1 * LDK] = (bf16_t)(w.x >> 16);
      vp[2 * LDK] = (bf16_t)(w.y & 0xffff); vp[3 * LDK] = (bf16_t)(w.y >> 16);
      vp[4 * LDK] = (bf16_t)(w.z & 0xffff); vp[5 * LDK] = (bf16_t)(w.z >> 16);
      vp[6 * LDK] = (bf16_t)(w.w & 0xffff); vp[7 * LDK] = (bf16_t)(w.w >> 16);
    }
  }
  __syncthreads();
  const float s0 = sums[k], s1 = sums[128 + k];
  const float total = s0 + s1;
  float run = th ? s0 : 0.f;
#pragma unroll
  for (int j = 0; j < 32; ++j) {
    run += lf[j];
    kT[k * LDK + th * 32 + j] = f2bf(ky[j] * __expf(total - run));
  }
  if (th == 0) DC[k] = __expf(total);
  __syncthreads();
  const int lane = tid & 63, wave = tid >> 6, fr = lane & 15, fq = lane >> 4;
  f32x4 acc[2][8];
#pragma unroll
  for (int i = 0; i < 2; ++i)
#pragma unroll
    for (int j = 0; j < 8; ++j) acc[i][j] = zero4();
#pragma unroll
  for (int ss = 0; ss < 2; ++ss) {
    bf16x8 bk[2];
#pragma unroll
    for (int i = 0; i < 2; ++i) bk[i] = *(const bf16x8*)(kT + (wave * 32 + i * 16 + fr) * LDK + ss * 32 + fq * 8);
#pragma unroll
    for (int j = 0; j < 8; ++j) {
      const bf16x8 av = *(const bf16x8*)(vT + (j * 16 + fr) * LDK + ss * 32 + fq * 8);
#pragma unroll
      for (int i = 0; i < 2; ++i) acc[i][j] = MFMA16(bk[i], av, acc[i][j]);
    }
  }
#pragma unroll
  for (int i = 0; i < 2; ++i)
#pragma unroll
    for (int j = 0; j < 8; ++j) store_bf4(SB + (j * 16 + fr) * 128 + wave * 32 + i * 16 + fq * 4, acc[i][j]);
  __syncthreads();
}
DI void hg2_item(const Params& p, int item, int tid) {
  const int gid = item * 256 + tid;
  const int bhh = gid >> 13, rem = gid & 8191, v = rem >> 6, k2 = (rem & 63) * 2;
  bf16_t* SB = (bf16_t*)(p.ws + O_SBUF) + (size_t)bhh * 256 * 16384 + v * 128 + k2;
  const float* DC = (const float*)(p.ws + O_DCY) + (size_t)bhh * 256 * 128 + k2;
  float s0 = 0.f, s1 = 0.f;
  for (int c = 0; c < 256; c += 8) {
    unsigned tmp[8]; f32x2 dc[8];
#pragma unroll
    for (int u = 0; u < 8; ++u) { tmp[u] = *(const unsigned*)(SB + (size_t)(c + u) * 16384); dc[u] = *(const f32x2*)(DC + (c + u) * 128); }
#pragma unroll
    for (int u = 0; u < 8; ++u) {
      *(unsigned*)(SB + (size_t)(c + u) * 16384) = pk2(s0, s1);
      s0 = dc[u][0] * s0 + bflo(tmp[u]);
      s1 = dc[u][1] * s1 + bfhi(tmp[u]);
    }
  }
}
DI void hg3_item(const Params& p, int l, int ch, unsigned char* smem, int tid) {
  bf16_t* QK = (bf16_t*)(p.ws + O_QK);
  const bf16_t* SB = (const bf16_t*)(p.ws + O_SBUF) + (size_t)ch * 16384;
  const int bhh = ch >> 8, c = ch & 255, b = bhh >> 2, h = bhh & 3;
  const size_t row0 = (size_t)b * S_ + c * 64;
  bf16_t* qi = (bf16_t*)smem;
  bf16_t* qa = qi + 64 * LDH;
  bf16_t* ka = qa + 64 * LDH;
  bf16_t* vT = ka + 64 * LDH;
  float* sums = (float*)(vT + 128 * LDK);
  const int k = tid & 127, th = tid >> 7;
  const float lb = hg_lb_of(p, l, h * 128 + k);
  float lf[32], ky[32];
  float loc = 0.f;
  const bf16_t* zf = QK + (row0 + th * 32) * 4096 + 5 * 512 + h * 128 + k;
  const bf16_t* zq = QK + (row0 + th * 32) * 4096 + 4 * 512 + h * 128 + k;
#pragma unroll
  for (int j = 0; j < 32; ++j) {
    hg_gate(bf2f(zf[(size_t)j * 4096]), lb, lf[j], ky[j]);
    loc += lf[j];
  }
  if (th == 0) sums[k] = loc;
  {
    const int s = tid & 63, vc = (tid >> 6) * 8;
#pragma unroll
    for (int i = 0; i < 4; ++i) {
      const u32x4 w = *(const u32x4*)(QK + (row0 + s) * 4096 + 6 * 512 + h * 128 + vc + 32 * i);
      bf16_t* vp = vT + (vc + 32 * i) * LDK + s;
      vp[0 * LDK] = (bf16_t)(w.x & 0xffff); vp[1 * LDK] = (bf16_t)(w.x >> 16);
      vp[2 * LDK] = (bf16_t)(w.y & 0xffff); vp[3 * LDK] = (bf16_t)(w.y >> 16);
      vp[4 * LDK] = (bf16_t)(w.z & 0xffff); vp[5 * LDK] = (bf16_t)(w.z >> 16);
      vp[6 * LDK] = (bf16_t)(w.w & 0xffff); vp[7 * LDK] = (bf16_t)(w.w >> 16);
    }
  }
  __syncthreads();
  {
    const float bmid = sums[k];
    float run = th ? bmid : 0.f;
#pragma unroll
    for (int j = 0; j < 32; ++j) {
      run += lf[j];
      const float qz = bf2f(zq[(size_t)j * 4096]);
      const float qs = qz * sigmoidf_(qz);
      const int t = th * 32 + j;
      const float er = __expf(run - bmid);
      qi[t * LDH + k] = f2bf(qs * __expf(run));
      qa[t * LDH + k] = f2bf(qs * er);
      ka[t * LDH + k] = f2bf(ky[j] / er);
    }
  }
  __syncthreads();
  const int lane = tid & 63, wave = tid >> 6, fr = lane & 15, fq = lane >> 4;
  const int tcol = wave * 16 + fr;
  f32x4 sc[4];
#pragma unroll
  for (int i = 0; i < 4; ++i) sc[i] = zero4();
#pragma unroll
  for (int kk = 0; kk < 4; ++kk) {
    const bf16x8 bq = *(const bf16x8*)(qa + tcol * LDH + kk * 32 + fq * 8);
#pragma unroll
    for (int sf = 0; sf < 4; ++sf) {
      const bf16x8 a = *(const bf16x8*)(ka + (sf * 16 + fr) * LDH + kk * 32 + fq * 8);
      sc[sf] = MFMA16(a, bq, sc[sf]);
    }
  }
#pragma unroll
  for (int sf = 0; sf < 4; ++sf)
#pragma unroll
    for (int r = 0; r < 4; ++r) { const int s = sf * 16 + fq * 4 + r; if (s > tcol) sc[sf][r] = 0.f; }
  f32x4 o[8];
#pragma unroll
  for (int j = 0; j < 8; ++j) o[j] = zero4();
#pragma unroll
  for (int ss = 0; ss < 2; ++ss) {
    const bf16x8 pb = pack8(sc[2 * ss], sc[2 * ss + 1]);
#pragma unroll
    for (int j = 0; j < 8; ++j) {
      const bf16_t* vp = vT + (j * 16 + fr) * LDK + ss * 32 + fq * 4;
      const bf16x8 a = cat4(*(const bf16x4*)vp, *(const bf16x4*)(vp + 16));
      o[j] = MFMA16(a, pb, o[j]);
    }
  }
#pragma unroll
  for (int kk = 0; kk < 4; ++kk) {
    const bf16x8 bq = *(const bf16x8*)(qi + tcol * LDH + kk * 32 + fq * 8);
#pragma unroll
    for (int j = 0; j < 8; ++j) {
      const bf16x8 a = *(const bf16x8*)(SB + (j * 16 + fr) * 128 + kk * 32 + fq * 8);
      o[j] = MFMA16(a, bq, o[j]);
    }
  }
  float ss = 0.f;
#pragma unroll
  for (int j = 0; j < 8; ++j) ss += o[j][0] * o[j][0] + o[j][1] * o[j][1] + o[j][2] * o[j][2] + o[j][3] * o[j][3];
  ss += __shfl_xor(ss, 16, 64); ss += __shfl_xor(ss, 32, 64);
  const float rs = rsqrtf(ss * (1.f / 128.f) + EPS);
  const float* gn = p.hg_onorm + l * 128;
  const size_t row = row0 + tcol;
#pragma unroll
  for (int j = 0; j < 8; ++j) {
    const int v = j * 16 + fq * 4;
    const f32x4 g4 = *(const f32x4*)(gn + v);
    const u32x2 gw = *(const u32x2*)(QK + row * 4096 + 7 * 512 + h * 128 + v);
    f32x4 gg = {bflo(gw.x), bfhi(gw.x), bflo(gw.y), bfhi(gw.y)};
    f32x4 y;
#pragma unroll
    for (int r = 0; r < 4; ++r) y[r] = o[j][r] * rs * g4[r] * gg[r] * sigmoidf_(gg[r]);
    store_bf4(QK + row * 4096 + 4 * 512 + h * 128 + v, y);
  }
  __syncthreads();
}

struct S5c { float abr, abi; };
DI void s5_consts(const Params& p, int l, int g, int lp, float& abr, float& abi, float& cfr, float& cfi) {
  const float dt = __expf(p.s5_log_dt[l * 32 + g]);
  const float ar = p.s5_a_re[(l * 32 + g) * 64 + lp], ai = p.s5_a_im[(l * 32 + g) * 64 + lp];
  const float mag = __expf(dt * ar);
  const float x = dt * ai;
  const float kq = rintf(x * 0.636619772367581343f);
  float r = fmaf(-kq, 1.5707855225e+00f, x);
  r = fmaf(-kq, 1.0804334124e-05f, r);
  const float r2 = r * r;
  const float sp_ = r + r * r2 * (-1.6666667163e-01f + r2 * (8.3333337680e-03f + r2 * (-1.9841270114e-04f + r2 * 2.7557314297e-06f)));
  const float cp_ = 1.f - 0.5f * r2 + r2 * r2 * (4.1666667908e-02f + r2 * (-1.3888889225e-03f + r2 * (2.4801587642e-05f + r2 * -2.7557314297e-07f)));
  const int nq = ((int)kq) & 3;
  const float sn = (nq == 0) ? sp_ : (nq == 1) ? cp_ : (nq == 2) ? -sp_ : -cp_;
  const float cs = (nq == 0) ? cp_ : (nq == 1) ? -sp_ : (nq == 2) ? -cp_ : sp_;
  abr = mag * cs; abi = mag * sn;
  const float inv = 1.f / (ar * ar + ai * ai);
  const float nr = abr - 1.f, ni = abi;
  cfr = (nr * ar + ni * ai) * inv;
  cfi = (ni * ar - nr * ai) * inv;
}
DI void s5tab_item(const Params& p, int l, int item, int tid) {
  const int gid = item * 256 + tid;
  const int g = gid >> 6, lp = gid & 63;
  float abr, abi, cfr, cfi;
  s5_consts(p, l, g, lp, abr, abi, cfr, cfi);
  float* tb = (float*)(p.ws + O_S5T) + (size_t)gid * 36;
  const float* br = p.s5_b_re + ((size_t)(l * 32 + g) * 64 + lp) * 16;
  const float* bi = p.s5_b_im + ((size_t)(l * 32 + g) * 64 + lp) * 16;
  *(f32x4*)tb = (f32x4){abr, abi, 0.f, 0.f};
#pragma unroll
  for (int q = 0; q < 4; ++q) {
    const f32x4 r4 = *(const f32x4*)(br + q * 4), i4 = *(const f32x4*)(bi + q * 4);
    *(f32x4*)(tb + 4 + q * 4) = cfr * r4 - cfi * i4;
    *(f32x4*)(tb + 20 + q * 4) = cfr * i4 + cfi * r4;
  }
}
DI void s5_load(const Params& p, int g, int lane, float& abr, float& abi, float (&bbr)[16], float (&bbi)[16]) {
  const float* tb = (const float*)(p.ws + O_S5T) + (size_t)(g * 64 + lane) * 36;
  const f32x4 a = *(const f32x4*)tb;
  abr = a[0]; abi = a[1];
#pragma unroll
  for (int q = 0; q < 4; ++q) {
    const f32x4 r4 = *(const f32x4*)(tb + 4 + q * 4), i4 = *(const f32x4*)(tb + 20 + q * 4);
#pragma unroll
    for (int e = 0; e < 4; ++e) { bbr[q * 4 + e] = r4[e]; bbi[q * 4 + e] = i4[e]; }
  }
}
DI void s5a_item(const Params& p, int l, int item, unsigned char* smem, int tid) {
  const bf16_t* QK = (const bf16_t*)(p.ws + O_QK);
  f32x2* E = (f32x2*)(p.ws + O_S5E);
  const int lane = tid & 63, wave = tid >> 6;
  const int wi = item * 4 + wave;
  const int g = wi & 31, c = (wi >> 5) & 127, b = wi >> 12;
  float* us = (float*)smem + wave * 2048;
  float abr, abi;
  float bbr[16], bbi[16];
  s5_load(p, g, lane, abr, abi, bbr, bbi);
  const size_t row0 = (size_t)b * S_ + c * 128;
#pragma unroll
  for (int i = 0; i < 2; ++i) {
    const int t = lane + 64 * i;
    const bf16_t* up = QK + (row0 + t) * 4096 + 3 * 512 + g * 16;
    const u32x4 w0 = *(const u32x4*)up, w1 = *(const u32x4*)(up + 8);
    float* d = us + t * 16;
    *(f32x4*)(d + 0) = (f32x4){bflo(w0.x), bfhi(w0.x), bflo(w0.y), bfhi(w0.y)};
    *(f32x4*)(d + 4) = (f32x4){bflo(w0.z), bfhi(w0.z), bflo(w0.w), bfhi(w0.w)};
    *(f32x4*)(d + 8) = (f32x4){bflo(w1.x), bfhi(w1.x), bflo(w1.y), bfhi(w1.y)};
    *(f32x4*)(d + 12) = (f32x4){bflo(w1.z), bfhi(w1.z), bflo(w1.w), bfhi(w1.w)};
  }
  __builtin_amdgcn_fence(__ATOMIC_RELEASE, "wavefront"); __builtin_amdgcn_wave_barrier(); __builtin_amdgcn_fence(__ATOMIC_ACQUIRE, "wavefront");
  float hr = 0.f, hi = 0.f;
  float ur[2][16];
#pragma unroll
  for (int i = 0; i < 2; ++i)
#pragma unroll
    for (int h = 0; h < 16; ++h) ur[i][h] = us[(lane + 64 * i) * 16 + h];
#pragma unroll
  for (int i = 0; i < 2; ++i) {
    for (int tt = 0; tt < 64; ++tt) {
      float dr = 0.f, di = 0.f;
#pragma unroll
      for (int h = 0; h < 16; ++h) {
        const float uh = __int_as_float(__builtin_amdgcn_readlane(__float_as_int(ur[i][h]), tt));
        dr += bbr[h] * uh; di += bbi[h] * uh;
      }
      const float nr = abr * hr - abi * hi + dr;
      const float ni = abr * hi + abi * hr + di;
      hr = nr; hi = ni;
    }
  }
  E[((size_t)(b * 32 + g) * 128 + c) * 64 + lane] = (f32x2){hr, hi};
}
DI void s5b_item(const Params& p, int l, int item, int tid) {
  const int gid = item * 256 + tid;
  const int bg = gid >> 6, lp = gid & 63, g = bg & 31;
  const f32x4 ab4 = *(const f32x4*)((const float*)(p.ws + O_S5T) + (size_t)(g * 64 + lp) * 36);
  const float abr = ab4[0], abi = ab4[1];
  float pr = abr, pi = abi;
#pragma unroll
  for (int i = 0; i < 7; ++i) { const float nr = pr * pr - pi * pi, ni = 2.f * pr * pi; pr = nr; pi = ni; }
  f32x2* E = (f32x2*)(p.ws + O_S5E) + (size_t)bg * 128 * 64 + lp;
  float hr = 0.f, hi = 0.f;
  for (int c = 0; c < 128; c += 8) {
    f32x2 e[8];
#pragma unroll
    for (int u = 0; u < 8; ++u) e[u] = E[(size_t)(c + u) * 64];
#pragma unroll
    for (int u = 0; u < 8; ++u) {
      E[(size_t)(c + u) * 64] = (f32x2){hr, hi};
      const float nr = pr * hr - pi * hi + e[u][0];
      const float ni = pr * hi + pi * hr + e[u][1];
      hr = nr; hi = ni;
    }
  }
}
DI float gelu_tanh(float y) {
  const float u = 1.5957691216057308f * (y + 0.044715f * y * y * y);
  return y * __builtin_amdgcn_rcpf(1.f + __expf(-u));
}
DI void s5c_item(const Params& p, int l, int item, unsigned char* smem, int tid) {
  bf16_t* QK = (bf16_t*)(p.ws + O_QK);
  const f32x2* E = (const f32x2*)(p.ws + O_S5E);
  const int lane = tid & 63, wave = tid >> 6, fr = lane & 15, fq = lane >> 4;
  const int wi = item * 4 + wave;
  const int g = wi & 31, c = (wi >> 5) & 127, b = wi >> 12;
  float* us = (float*)smem + wave * 2048;
  bf16_t* Hs = (bf16_t*)(smem + 32768) + wave * 16 * LDH;
  float abr, abi;
  float bbr[16], bbi[16];
  s5_load(p, g, lane, abr, abi, bbr, bbi);
  bf16x8 cop[4];
#pragma unroll
  for (int kk = 0; kk < 4; ++kk) {
    const int k = kk * 32 + fq * 8;
    const float* src = (k < 64 ? p.s5_c_re : p.s5_c_im) + ((size_t)(l * 32 + g) * 16 + fr) * 64 + (k & 63);
    const float sg = k < 64 ? 1.f : -1.f;
    const f32x4 a = *(const f32x4*)src * sg, bq = *(const f32x4*)(src + 4) * sg;
    cop[kk] = pack8(a, bq);
  }
  const f32x4 dsk = *(const f32x4*)(p.s5_d + l * 512 + g * 16 + fq * 4);
  const size_t row0 = (size_t)b * S_ + c * 128;
#pragma unroll
  for (int i = 0; i < 2; ++i) {
    const int t = lane + 64 * i;
    const bf16_t* up = QK + (row0 + t) * 4096 + 3 * 512 + g * 16;
    const u32x4 w0 = *(const u32x4*)up, w1 = *(const u32x4*)(up + 8);
    float* d = us + t * 16;
    *(f32x4*)(d + 0) = (f32x4){bflo(w0.x), bfhi(w0.x), bflo(w0.y), bfhi(w0.y)};
    *(f32x4*)(d + 4) = (f32x4){bflo(w0.z), bfhi(w0.z), bflo(w0.w), bfhi(w0.w)};
    *(f32x4*)(d + 8) = (f32x4){bflo(w1.x), bfhi(w1.x), bflo(w1.y), bfhi(w1.y)};
    *(f32x4*)(d + 12) = (f32x4){bflo(w1.z), bfhi(w1.z), bflo(w1.w), bfhi(w1.w)};
  }
  const f32x2 e0 = E[((size_t)(b * 32 + g) * 128 + c) * 64 + lane];
  float hr = e0[0], hi = e0[1];
  __builtin_amdgcn_fence(__ATOMIC_RELEASE, "wavefront"); __builtin_amdgcn_wave_barrier(); __builtin_amdgcn_fence(__ATOMIC_ACQUIRE, "wavefront");
  float ur[2][16];
#pragma unroll
  for (int i = 0; i < 2; ++i)
#pragma unroll
    for (int h = 0; h < 16; ++h) ur[i][h] = us[(lane + 64 * i) * 16 + h];
#pragma unroll
  for (int ih = 0; ih < 2; ++ih)
  for (int tb4 = 0; tb4 < 4; ++tb4) {
    const int tb = ih * 4 + tb4;
    for (int tt = 0; tt < 16; ++tt) {
      const int ln = tb4 * 16 + tt;
      float dr = 0.f, di = 0.f;
#pragma unroll
      for (int h = 0; h < 16; ++h) {
        const float uh = __int_as_float(__builtin_amdgcn_readlane(__float_as_int(ur[ih][h]), ln));
        dr += bbr[h] * uh; di += bbi[h] * uh;
      }
      const float nr = abr * hr - abi * hi + dr;
      const float ni = abr * hi + abi * hr + di;
      hr = nr; hi = ni;
      Hs[tt * LDH + lane] = f2bf(hr);
      Hs[tt * LDH + 64 + lane] = f2bf(hi);
    }
    __builtin_amdgcn_fence(__ATOMIC_RELEASE, "wavefront"); __builtin_amdgcn_wave_barrier(); __builtin_amdgcn_fence(__ATOMIC_ACQUIRE, "wavefront");
    f32x4 y = zero4();
#pragma unroll
    for (int kk = 0; kk < 4; ++kk) {
      const bf16x8 hb = *(const bf16x8*)(Hs + fr * LDH + kk * 32 + fq * 8);
      y = MFMA16(cop[kk], hb, y);
    }
    const int t = tb * 16 + fr;
    const f32x4 u4 = *(const f32x4*)(us + t * 16 + fq * 4);
    f32x4 z;
#pragma unroll
    for (int r = 0; r < 4; ++r) z[r] = gelu_tanh(y[r] + dsk[r] * u4[r]);
    store_bf4(QK + (row0 + t) * 4096 + 3 * 512 + g * 16 + fq * 4, z);
    __builtin_amdgcn_fence(__ATOMIC_RELEASE, "wavefront"); __builtin_amdgcn_wave_barrier(); __builtin_amdgcn_fence(__ATOMIC_ACQUIRE, "wavefront");
  }
}

DI void kxnorm_item(const Params& p, int l, int item, int tid) {
  const int lane = tid & 63, wave = tid >> 6;
  const int wi = item * 4 + wave;
  const int row = wi >> 2, hd = wi & 3;
  const float* src = (const float*)(p.ws + O_KXR) + (size_t)row * 1024 + hd * 256 + lane * 4;
  const f32x4 v = *(const f32x4*)src;
  float ss = v[0] * v[0] + v[1] * v[1] + v[2] * v[2] + v[3] * v[3];
  ss = wave_sum(ss);
  const float rs = rsqrtf(ss * (1.f / 256.f) + EPS);
  const f32x4 g4 = *(const f32x4*)(p.x_knorm + l * 256 + lane * 4);
  store_bf4((bf16_t*)(p.ws + O_KXN) + (size_t)row * 1024 + hd * 256 + lane * 4, v * rs * g4);
}
constexpr int LDX = 264;
DI void xattn_item(const Params& p, int l, int item, unsigned char* smem, int tid) {
  const bf16_t* QX = (const bf16_t*)(p.ws + O_QK);
  bf16_t* OX = (bf16_t*)(p.ws + O_QK) + (size_t)T_ * 1024;
  const bf16_t* KXN = (const bf16_t*)(p.ws + O_KXN);
  const bf16_t* VXT = (const bf16_t*)(p.ws + O_VXT);
  const int lane = tid & 63, wave = tid >> 6, fr = lane & 15, fq = lane >> 4;
  const int hd = item & 3, rt = item >> 2;
  const int b = rt >> 8;
  const size_t row = (size_t)rt * 64 + wave * 16 + fr;
  bf16_t* sT = (bf16_t*)smem;
  bf16x8 qf[8];
  {
    float ss = 0.f;
    f32x4 qa[8][2];
    const bf16_t* qp = QX + row * 1024 + hd * 256 + fq * 8;
#pragma unroll
    for (int kk = 0; kk < 8; ++kk) {
      const u32x4 w = *(const u32x4*)(qp + kk * 32);
      qa[kk][0] = (f32x4){bflo(w.x), bfhi(w.x), bflo(w.y), bfhi(w.y)};
      qa[kk][1] = (f32x4){bflo(w.z), bfhi(w.z), bflo(w.w), bfhi(w.w)};
#pragma unroll
      for (int e = 0; e < 4; ++e) ss += qa[kk][0][e] * qa[kk][0][e] + qa[kk][1][e] * qa[kk][1][e];
    }
    ss += __shfl_xor(ss, 16, 64); ss += __shfl_xor(ss, 32, 64);
    const float rs = rsqrtf(ss * (1.f / 256.f) + EPS) * (0.0625f * LOG2E);
    const float* gq = p.x_qnorm + l * 256 + fq * 8;
#pragma unroll
    for (int kk = 0; kk < 8; ++kk) {
      const f32x4 g0 = *(const f32x4*)(gq + kk * 32), g1 = *(const f32x4*)(gq + kk * 32 + 4);
      qf[kk] = pack8(qa[kk][0] * rs * g0, qa[kk][1] * rs * g1);
    }
  }
  f32x4 s[16];
#pragma unroll
  for (int i = 0; i < 16; ++i) s[i] = zero4();
#pragma unroll
  for (int jt = 0; jt < 4; ++jt) {
#pragma unroll
    for (int i = 0; i < 8; ++i) {
      const int cidx = tid + 256 * i, key = cidx >> 5, dc = (cidx & 31) * 8;
      *(u32x4*)(sT + key * LDX + dc) = *(const u32x4*)(KXN + ((size_t)b * 256 + jt * 64 + key) * 1024 + hd * 256 + dc);
    }
    __syncthreads();
#pragma unroll
    for (int kk = 0; kk < 8; ++kk)
#pragma unroll
      for (int mf = 0; mf < 4; ++mf) {
        const bf16x8 a = *(const bf16x8*)(sT + (mf * 16 + fr) * LDX + kk * 32 + fq * 8);
        s[jt * 4 + mf] = MFMA16(a, qf[kk], s[jt * 4 + mf]);
      }
    __syncthreads();
  }
  float mx = -1e30f;
#pragma unroll
  for (int i = 0; i < 16; ++i)
#pragma unroll
    for (int r = 0; r < 4; ++r) mx = fmaxf(mx, s[i][r]);
  mx = fmaxf(mx, __shfl_xor(mx, 16, 64)); mx = fmaxf(mx, __shfl_xor(mx, 32, 64));
  float ls = 0.f;
#pragma unroll
  for (int i = 0; i < 16; ++i)
#pragma unroll
    for (int r = 0; r < 4; ++r) { const float pv = ex2(s[i][r] - mx); s[i][r] = pv; ls += pv; }
  ls += __shfl_xor(ls, 16, 64); ls += __shfl_xor(ls, 32, 64);
  const float inv = 1.f / ls;
  bf16x8 pp[8];
#pragma unroll
  for (int i = 0; i < 8; ++i) pp[i] = pack8(s[2 * i], s[2 * i + 1]);
  f32x4 o[16];
#pragma unroll
  for (int i = 0; i < 16; ++i) o[i] = zero4();
#pragma unroll
  for (int jt = 0; jt < 4; ++jt) {
#pragma unroll
    for (int i = 0; i < 8; ++i) {
      const int cidx = tid + 256 * i, d = cidx >> 3, mc = (cidx & 7) * 8;
      *(u32x4*)(sT + d * LDK + mc) = *(const u32x4*)(VXT + ((size_t)b * 1024 + hd * 256 + d) * 256 + jt * 64 + mc);
    }
    __syncthreads();
#pragma unroll
    for (int ss = 0; ss < 2; ++ss) {
      const bf16x8 pb = pp[jt * 2 + ss];
#pragma unroll
      for (int df = 0; df < 16; ++df) {
        const bf16_t* vp = sT + (df * 16 + fr) * LDK + ss * 32 + fq * 4;
        const bf16x8 a = cat4(*(const bf16x4*)vp, *(const bf16x4*)(vp + 16));
        o[df] = MFMA16(a, pb, o[df]);
      }
    }
    __syncthreads();
  }
  bf16_t* op = OX + row * 1024 + hd * 256 + fq * 4;
#pragma unroll
  for (int df = 0; df < 16; ++df) store_bf4(op + df * 16, o[df] * inv);
}

__global__ void __launch_bounds__(512, 2) mega(Params p, int ph_lo, int ph_hi, int coop) {
  __shared__ __attribute__((aligned(16))) unsigned char smem_all[147456];
#ifdef DIAG_ZERO
  if (ph_lo == 0) {
    u32x4* w4 = (u32x4*)p.ws;
    const u32x4 z4 = {0u, 0u, 0u, 0u};
    for (size_t i = (size_t)blockIdx.x * 256 + threadIdx.x; i < O_END / 16; i += (size_t)gridDim.x * 256) w4[i] = z4;
    u32x4* o4 = (u32x4*)p.out;
    for (size_t i = (size_t)blockIdx.x * 256 + threadIdx.x; i < (size_t)T_ * 1024 / 4; i += (size_t)gridDim.x * 256) o4[i] = z4;
    for (int i = threadIdx.x; i < 73728 / 16; i += 256) ((u32x4*)smem)[i] = z4;
    __syncthreads();
    if (coop) cg::this_grid().sync();
  }
#endif
  if (coop) {
    if (blockIdx.x == 0 && threadIdx.x == 0) __hip_atomic_store((unsigned*)(p.ws + O_BAR), 0u, __ATOMIC_RELAXED, __HIP_MEMORY_SCOPE_AGENT);
    cg::this_grid().sync();
  }
  for (int ph = ph_lo; ph < ph_hi; ++ph) {
#ifdef REP_MASK
    const int nrep = ((REP_MASK >> (ph % NPH)) & 1) ? 2 : 1;
#else
    const int nrep = 1;
#endif
    for (int rep = 0; rep < nrep; ++rep) {
    int tid = threadIdx.x, G = gridDim.x * 2, bid = blockIdx.x * 2;
    asm volatile("" : "+v"(tid));
    asm volatile("" : "+s"(G));
    const int sub = __builtin_amdgcn_readfirstlane(tid >> 8);
    tid &= 255;
    bid += sub;
    unsigned char* smem = smem_all + sub * 73728;
    int t8 = threadIdx.x, WG = blockIdx.x, NWG = gridDim.x;
    asm volatile("" : "+v"(t8));
    asm volatile("" : "+s"(WG));
    asm volatile("" : "+s"(NWG));
    const int wr8 = t8 >> 7, wc8 = (t8 >> 6) & 1;
    const int wr2 = t8 >> 8, wc4 = (t8 >> 6) & 3;
    const int lane = tid & 63, wave = tid >> 6, wr = wave >> 1, wc = wave & 1, fr = lane & 15, fq = lane >> 4;
    unsigned char* ws = p.ws;
    asm volatile("" : "+s"(ws));
    bf16_t* HB = (bf16_t*)(ws + O_HB);
    bf16_t* QK = (bf16_t*)(ws + O_QK);
    const int l = ph / NPH;
#ifdef ONLY_SP
    const int sp = ONLY_SP;
#else
    const int sp = ph % NPH;
#endif
    const float* xin = (l == 0) ? p.x : p.out;
    if (sp == 0) {
      float* wfft = (float*)smem;
      bf16_t* ctile = (bf16_t*)(smem + 32768);
      {
        const float* wsrc = p.w_in + (size_t)l * D_ * INC + 1536;
        for (int i = tid; i < 2048; i += 256) {
          const int k = i >> 1, j4 = (i & 1) * 4;
          const f32x4 v = *(const f32x4*)(wsrc + (size_t)k * INC + j4);
          wfft[(j4 + 0) * 1024 + k] = v[0]; wfft[(j4 + 1) * 1024 + k] = v[1];
          wfft[(j4 + 2) * 1024 + k] = v[2]; wfft[(j4 + 3) * 1024 + k] = v[3];
        }
        __syncthreads();
      }
      const int total = 1024 + 16 + N_CONV + 8;
      for (int it = bid; it < total; it += G) {
        if (it < 1024) norm_item(xin, p.norm_mix + l * 1024, HB, it * 32, wfft, (float*)(ws + O_LOGF), p.fox_fbias + l * 8, tid);
        else if (it < 1040) norm_item(p.mem, p.norm_mem + l * 1024, (bf16_t*)(ws + O_MEMN), (it - 1024) * 32, nullptr, nullptr, nullptr, tid);
        else if (it < 1040 + N_CONV) conv_item(p, l, it - 1040, ctile, tid);
        else s5tab_item(p, l, it - 1040 - N_CONV, tid);
      }
    } else if (sp == 1) {
      for (int it = bid; it < 16 + 64; it += G) {
        if (it < 16) { cumsum_item(p, it, smem, tid); continue; }
        f32x4 acc[4][4];
        zero_acc<4>(acc);
        const int t = it - 16, nt = t & 15, mt = t >> 4;
        const int m0 = mt * 128, n0 = (nt & 7) * 128;
        const bf16_t* W = (const bf16_t*)(ws + (nt < 8 ? O_WXK : O_WXV));
        gemm_core<4>((const bf16_t*)(ws + O_MEMN) + (size_t)m0 * 1024, 1024, W + (size_t)n0 * 1024, 1024, 1024, acc, smem, tid);
        if (nt < 8) {
          float* KXR = (float*)(ws + O_KXR);
#pragma unroll
          for (int mi = 0; mi < 4; ++mi) {
            const size_t row = m0 + wr * 64 + mi * 16 + fr;
#pragma unroll
            for (int ni = 0; ni < 4; ++ni) *(f32x4*)(KXR + row * 1024 + n0 + wc * 64 + ni * 16 + fq * 4) = acc[mi][ni];
          }
        } else {
          bf16_t* VXT = (bf16_t*)(ws + O_VXT);
#pragma unroll
          for (int mi = 0; mi < 4; ++mi) {
            const int row = m0 + wr * 64 + mi * 16 + fr, bb = row >> 8, mm = row & 255;
#pragma unroll
            for (int ni = 0; ni < 4; ++ni)
#pragma unroll
              for (int r = 0; r < 4; ++r) VXT[((size_t)bb * 1024 + n0 + wc * 64 + ni * 16 + fq * 4 + r) * 256 + mm] = f2bf(acc[mi][ni][r]);
          }
        }
      }
      for (int it = WG; it < 2048; it += NWG) {
        int nt, mt; xcd_tile(it, WG, NWG, 16, mt, nt);
        const int m0 = mt * 256, n0 = nt * 256;
        f32x4 acc[2][2][4][2];
        zero_acc8p(acc);
        gemm8p(HB + (size_t)m0 * 1024, 1024, (const bf16_t*)(ws + O_WP) + (size_t)n0 * 1024, 1024, 1024, acc, smem_all, t8);
        const int slot = n0 >> 9;
        if (slot < 2) {
          const float* gn = (slot == 0 ? p.fox_qnorm : p.fox_knorm) + l * 64 + (wc4 & 1) * 32 + fq * 4;
          const float scl = slot == 0 ? 0.125f * LOG2E : 1.f;
          float* xs = (float*)smem_all;
          const int wid8 = t8 >> 6;
          float part[2][2][4];
#pragma unroll
          for (int ai = 0; ai < 2; ++ai)
#pragma unroll
            for (int bj = 0; bj < 2; ++bj)
#pragma unroll
              for (int m = 0; m < 4; ++m) {
                float ss = 0.f;
#pragma unroll
                for (int n = 0; n < 2; ++n)
#pragma unroll
                  for (int r = 0; r < 4; ++r) ss += acc[ai][bj][m][n][r] * acc[ai][bj][m][n][r];
                ss += __shfl_xor(ss, 16, 64); ss += __shfl_xor(ss, 32, 64);
                part[ai][bj][m] = ss;
                if (fq == 0) xs[(wid8 * 16 + (ai * 2 + bj) * 4 + m) * 16 + fr] = ss;
              }
          __syncthreads();
          const f32x4 g0 = *(const f32x4*)gn, g1 = *(const f32x4*)(gn + 16);
#pragma unroll
          for (int ai = 0; ai < 2; ++ai)
#pragma unroll
            for (int m = 0; m < 4; ++m) {
              const size_t row = m0 + ai * 128 + wr2 * 64 + m * 16 + fr;
#pragma unroll
              for (int bj = 0; bj < 2; ++bj) {
                const float tot = part[ai][bj][m] + xs[((wid8 ^ 1) * 16 + (ai * 2 + bj) * 4 + m) * 16 + fr];
                const float rs = rsqrtf(tot * (1.f / 64.f) + EPS) * scl;
                bf16_t* dst = QK + row * 4096 + n0 + bj * 128 + wc4 * 32 + fq * 4;
                store_bf4(dst, acc[ai][bj][m][0] * rs * g0);
                store_bf4(dst + 16, acc[ai][bj][m][1] * rs * g1);
              }
            }
          __syncthreads();
        } else {
#pragma unroll
          for (int ai = 0; ai < 2; ++ai)
#pragma unroll
            for (int m = 0; m < 4; ++m) {
              const size_t row = m0 + ai * 128 + wr2 * 64 + m * 16 + fr;
#pragma unroll
              for (int bj = 0; bj < 2; ++bj)
#pragma unroll
                for (int n = 0; n < 2; ++n) store_bf4(QK + row * 4096 + n0 + bj * 128 + wc4 * 32 + n * 16 + fq * 4, acc[ai][bj][m][n]);
            }
        }
      }
    } else if (sp == 2) {
      const int total = 2048 + 2048 + 512;
      for (int it = bid; it < total; it += G) {
        if (it < 2048) hg1_item(p, l, it, smem, tid);
        else if (it < 4096) s5a_item(p, l, it - 2048, smem, tid);
        else kxnorm_item(p, l, it - 4096, tid);
      }
    } else if (sp == 3) {
      const int total = 256 + 16;
      for (int it = bid; it < total; it += G) {
        if (it < 256) hg2_item(p, it, tid);
        else s5b_item(p, l, it - 256, tid);
      }
    } else if (sp == 4) {
      for (int it = WG; it < 1024; it += NWG) {
        int idx = it;
        const int j = it / NWG;
        if ((j & 1) && (j + 1) * NWG <= 1024) idx = j * NWG + (NWG - 1 - (it - j * NWG));
        fox_item(p, l, idx, smem_all, t8);
      }
      for (int it = bid; it < 4096; it += G) {
        if (it < 2048) hg3_item(p, l, it, smem, tid);
        else s5c_item(p, l, it - 2048, smem, tid);
      }
    } else if (sp == 5) {
      const float* bg = p.s5_b_glu + l * 512;
      for (int it = WG; it < 256; it += NWG) {
        int nt, mt; xcd_tile(it, WG, NWG, 2, mt, nt);
        const int m0 = mt * 256, n0 = nt * 256;
        f32x4 acc[2][2][4][2];
        zero_acc8p(acc);
        gemm8p(QK + (size_t)m0 * 4096 + 3 * 512, 4096, (const bf16_t*)(ws + O_WGLU) + (size_t)n0 * 512, 512, 512, acc, smem_all, t8);
#pragma unroll
        for (int ai = 0; ai < 2; ++ai)
#pragma unroll
          for (int m = 0; m < 4; ++m) {
            const size_t row = m0 + ai * 128 + wr2 * 64 + m * 16 + fr;
#pragma unroll
            for (int bj = 0; bj < 2; ++bj)
#pragma unroll
              for (int n = 0; n < 2; ++n) {
                const int col = n0 + bj * 128 + wc4 * 32 + n * 16 + fq * 4;
                const f32x4 b4 = *(const f32x4*)(bg + col);
                const u32x2 zw = *(const u32x2*)(QK + row * 4096 + 3 * 512 + col);
                const f32x4 z = {bflo(zw.x), bfhi(zw.x), bflo(zw.y), bfhi(zw.y)};
                f32x4 y;
#pragma unroll
                for (int r = 0; r < 4; ++r) y[r] = z[r] * sigmoidf_(acc[ai][bj][m][n][r] + b4[r]);
                store_bf4(QK + row * 4096 + 5 * 512 + col, y);
              }
          }
      }
    } else if (sp == 6) {
      for (int it = WG; it < 512; it += NWG) {
        int nt, mt; xcd_tile(it, WG, NWG, 4, mt, nt);
        const int m0 = mt * 256, n0 = nt * 256;
#pragma unroll 1
        for (int br = 0; br < 3; ++br) {
          f32x4 acc[2][2][4][2];
          zero_acc8p(acc);
          gemm8p(HB + (size_t)m0 * 1024, 1024, (const bf16_t*)(ws + O_WG) + (size_t)(br * 1024 + n0) * 1024, 1024, 1024, acc, smem_all, t8);
          { int tq = threadIdx.x; asm volatile("" : "+v"(tq));
          u32x4* gs = (u32x4*)(ws + O_GS) + ((size_t)WG * 512 + tq) * 16;
#pragma unroll
          for (int ai = 0; ai < 2; ++ai)
#pragma unroll
            for (int bj = 0; bj < 2; ++bj)
#pragma unroll
              for (int m = 0; m < 4; ++m) {
                u32x4 g;
                g.x = pk2(sigmoidf_(acc[ai][bj][m][0][0]), sigmoidf_(acc[ai][bj][m][0][1]));
                g.y = pk2(sigmoidf_(acc[ai][bj][m][0][2]), sigmoidf_(acc[ai][bj][m][0][3]));
                g.z = pk2(sigmoidf_(acc[ai][bj][m][1][0]), sigmoidf_(acc[ai][bj][m][1][1]));
                g.w = pk2(sigmoidf_(acc[ai][bj][m][1][2]), sigmoidf_(acc[ai][bj][m][1][3]));
                gs[(ai * 2 + bj) * 4 + m] = g;
              }
          }
          zero_acc8p(acc);
          const bf16_t* Ab = br == 0 ? (const bf16_t*)(ws + O_YF) + (size_t)m0 * 512 : QK + (size_t)m0 * 4096 + (br == 1 ? 5 : 4) * 512;
          gemm8p(Ab, br == 0 ? 512 : 4096, (const bf16_t*)(ws + O_WBR) + (size_t)br * 1024 * 512 + (size_t)n0 * 512, 512, 512, acc, smem_all, t8);
          int tq2 = threadIdx.x; asm volatile("" : "+v"(tq2));
          const u32x4* gs = (const u32x4*)(ws + O_GS) + ((size_t)WG * 512 + tq2) * 16;
          const int fr_e = tq2 & 15, fq_e = (tq2 >> 4) & 3, wr_e = tq2 >> 8, wc_e = (tq2 >> 6) & 3;
#pragma unroll
          for (int ai = 0; ai < 2; ++ai)
#pragma unroll
            for (int m = 0; m < 4; ++m) {
              const size_t row = m0 + ai * 128 + wr_e * 64 + m * 16 + fr_e;
#pragma unroll
              for (int bj = 0; bj < 2; ++bj) {
                const u32x4 g = gs[(ai * 2 + bj) * 4 + m];
                bf16_t* dst = QK + row * 4096 + 512 + n0 + bj * 128 + wc_e * 32 + fq_e * 4;
                f32x4 v0 = acc[ai][bj][m][0] * (f32x4){bflo(g.x), bfhi(g.x), bflo(g.y), bfhi(g.y)};
                f32x4 v1 = acc[ai][bj][m][1] * (f32x4){bflo(g.z), bfhi(g.z), bflo(g.w), bfhi(g.w)};
                if (br > 0) {
                  const u32x2 o0 = *(const u32x2*)dst, o1 = *(const u32x2*)(dst + 16);
                  v0 += (f32x4){bflo(o0.x), bfhi(o0.x), bflo(o0.y), bfhi(o0.y)};
                  v1 += (f32x4){bflo(o1.x), bfhi(o1.x), bflo(o1.y), bfhi(o1.y)};
                }
                store_bf4(dst, v0);
                store_bf4(dst + 16, v1);
              }
            }
        }
      }
    } else if (sp == 7 || sp == 11 || sp == 14) {
      const bf16_t* A; int lda, K; const bf16_t* W;
      const float* rin;
      if (sp == 7) { A = QK + 512; lda = 4096; K = 1024; W = (const bf16_t*)(ws + O_WOUT); rin = xin; }
      else if (sp == 11) { A = QK + (size_t)T_ * 1024; lda = 1024; K = 1024; W = (const bf16_t*)(ws + O_WXO); rin = p.out; }
      else { A = QK; lda = DFF; K = DFF; W = (const bf16_t*)(ws + O_WD); rin = p.out; }
      for (int it = WG; it < 512; it += NWG) {
        int nt, mt; xcd_tile(it, WG, NWG, 4, mt, nt);
        const int m0 = mt * 256, n0 = nt * 256;
        f32x4 acc[2][2][4][2];
        zero_acc8p(acc);
        gemm8p(A + (size_t)m0 * lda, lda, W + (size_t)n0 * K, K, K, acc, smem_all, t8);
#pragma unroll
        for (int ai = 0; ai < 2; ++ai)
#pragma unroll
          for (int m = 0; m < 4; ++m) {
            const size_t row = m0 + ai * 128 + wr2 * 64 + m * 16 + fr;
#pragma unroll
            for (int bj = 0; bj < 2; ++bj)
#pragma unroll
              for (int n = 0; n < 2; ++n) {
                const size_t o = row * 1024 + n0 + bj * 128 + wc4 * 32 + n * 16 + fq * 4;
                *(f32x4*)(p.out + o) = *(const f32x4*)(rin + o) + acc[ai][bj][m][n];
              }
          }
      }
    } else if (sp == 8 || sp == 12) {
      const float* gn = (sp == 8 ? p.norm_x : p.norm_ffn) + l * 1024;
      for (int it = bid; it < 1024; it += G) norm_item(p.out, gn, HB, it * 32, nullptr, nullptr, nullptr, tid);
    } else if (sp == 9) {
      for (int it = WG; it < 512; it += NWG) {
        int nt, mt; xcd_tile(it, WG, NWG, 4, mt, nt);
        const int m0 = mt * 256, n0 = nt * 256;
        f32x4 acc[2][2][4][2];
        zero_acc8p(acc);
        gemm8p(HB + (size_t)m0 * 1024, 1024, (const bf16_t*)(ws + O_WXQ) + (size_t)n0 * 1024, 1024, 1024, acc, smem_all, t8);
#pragma unroll
        for (int ai = 0; ai < 2; ++ai)
#pragma unroll
          for (int m = 0; m < 4; ++m) {
            const size_t row = m0 + ai * 128 + wr2 * 64 + m * 16 + fr;
#pragma unroll
            for (int bj = 0; bj < 2; ++bj)
#pragma unroll
              for (int n = 0; n < 2; ++n) store_bf4(QK + row * 1024 + n0 + bj * 128 + wc4 * 32 + n * 16 + fq * 4, acc[ai][bj][m][n]);
          }
      }
    } else if (sp == 10) {
      for (int it = bid; it < 2048; it += G) xattn_item(p, l, it, smem, tid);
    } else if (sp == 13) {
      bool pre = false;
      for (int it = WG; it < 128 * 22; it += NWG) {
        int nt, mt; xcd_tile(it, WG, NWG, 22, mt, nt);
        const int m0 = mt * 256, n0 = nt * 256;
        f32x4 acc[2][2][4][2];
        zero_acc8p(acc);
        gemm8p(HB + (size_t)m0 * 1024, 1024, (const bf16_t*)(ws + O_WGU) + (size_t)n0 * 1024, 1024, 1024, acc, smem_all, t8, pre);
        pre = false;
        if (it + NWG < 128 * 22) {
          int nt1, mt1; xcd_tile(it + NWG, WG, NWG, 22, mt1, nt1);
          g8_issue(HB + (size_t)mt1 * 256 * 1024, 1024, (const bf16_t*)(ws + O_WGU) + (size_t)nt1 * 256 * 1024, 1024, smem_all, t8);
          pre = true;
        }
#pragma unroll
        for (int ai = 0; ai < 2; ++ai)
#pragma unroll
          for (int m = 0; m < 4; ++m) {
            const size_t row = m0 + ai * 128 + wr2 * 64 + m * 16 + fr;
#pragma unroll
            for (int bj = 0; bj < 2; ++bj) {
              f32x4 y;
#pragma unroll
              for (int r = 0; r < 4; ++r) { const float a = acc[ai][bj][m][0][r]; y[r] = a * sigmoidf_(a) * acc[ai][bj][m][1][r]; }
              store_bf4(QK + row * DFF + nt * 128 + bj * 64 + wc4 * 16 + fq * 4, y);
            }
          }
      }
    }
    }
    if (coop && ph + 1 < ph_hi) {
      unsigned* bar = (unsigned*)(p.ws + O_BAR);
      __builtin_amdgcn_fence(__ATOMIC_RELEASE, "workgroup");
      asm volatile("s_waitcnt vmcnt(0)" ::: "memory");
      __syncthreads();
      if (threadIdx.x == 0) {
        const unsigned target = (unsigned)(ph - ph_lo + 1) * gridDim.x;
        __builtin_amdgcn_fence(__ATOMIC_RELEASE, "agent");
        __hip_atomic_fetch_add(bar, 1u, __ATOMIC_RELAXED, __HIP_MEMORY_SCOPE_AGENT);
        while (__hip_atomic_load(bar, __ATOMIC_RELAXED, __HIP_MEMORY_SCOPE_AGENT) < target) __builtin_amdgcn_s_sleep(1);
        __builtin_amdgcn_fence(__ATOMIC_ACQUIRE, "agent");
      }
      __syncthreads();
    }
#ifdef EXTRA_SYNC
    if (coop) for (int e = 0; e < EXTRA_SYNC; ++e) cg::this_grid().sync();
#endif
  }
}

extern "C" void kernel_launch(void* const* d_in, const int* in_sizes, int n_in, void* d_out, int out_size, void* d_ws,
                              size_t ws_size, hipStream_t stream) {
  Params p{};
  const float** pp = (const float**)&p;
  for (int i = 0; i < 32; ++i) pp[i] = (const float*)d_in[i];
  p.out = (float*)d_out;
  p.ws = (unsigned char*)d_ws;
  if (ws_size < O_END) return;
  static int grid = 0;
  if (!grid) {
    int dev = 0, cus = 0, per_cu = 0;
    hipGetDevice(&dev);
    hipDeviceGetAttribute(&cus, hipDeviceAttributeMultiprocessorCount, dev);
    hipOccupancyMaxActiveBlocksPerMultiprocessor(&per_cu, mega, 512, 0);
    if (per_cu < 1) per_cu = 1;
    if (per_cu > 1) per_cu = 1;
    grid = cus * per_cu;
  }
#if MK_MULTI
  for (int ph = 0; ph < NL * NPH; ++ph) hipLaunchKernelGGL(mega, dim3(grid), dim3(512), 0, stream, p, ph, ph + 1, 0);
#else
  int lo = 0, hi = NL * NPH, coop = 1;
  void* args[] = {&p, &lo, &hi, &coop};
  hipError_t e = hipLaunchCooperativeKernel((void*)mega, dim3(grid), dim3(512), args, 0, stream);
  if (e != hipSuccess) fprintf(stderr, "cooperative launch failed: %s (grid %d)\n", hipGetErrorString(e), grid);
#endif
}
```

```cpp
#include <hip/hip_runtime.h>
#include <hip/hip_cooperative_groups.h>
#include <cstdio>
#include <cstdint>
namespace cg = cooperative_groups;

#ifndef MK_MULTI
#define MK_MULTI 0
#endif

typedef unsigned short bf16_t;
typedef short bf16x8 __attribute__((ext_vector_type(8)));
typedef short bf16x4 __attribute__((ext_vector_type(4)));
typedef float f32x4 __attribute__((ext_vector_type(4)));
typedef float f32x2 __attribute__((ext_vector_type(2)));
typedef __bf16 hbf2 __attribute__((ext_vector_type(2)));
typedef unsigned u32x4 __attribute__((ext_vector_type(4)));
typedef unsigned u32x2 __attribute__((ext_vector_type(2)));

#define DI __device__ __forceinline__
#define MFMA16(a, b, c) __builtin_amdgcn_mfma_f32_16x16x32_bf16((a), (b), (c), 0, 0, 0)

constexpr int T_ = 32768, S_ = 16384, D_ = 1024, NL = 4;
constexpr int INC = 7176, DFF = 2816;
constexpr float LOG2E = 1.4426950408889634f;
constexpr float EPS = 1e-6f;
constexpr int NPH = 15;

constexpr size_t O_WP = 0;
constexpr size_t O_WG = O_WP + 4096ull * 1024 * 2;
constexpr size_t O_WBR = O_WG + 3072ull * 1024 * 2;
constexpr size_t O_WOUT = O_WBR + 3ull * 1024 * 512 * 2;
constexpr size_t O_WXQ = O_WOUT + 1024ull * 1024 * 2;
constexpr size_t O_WXK = O_WXQ + 1024ull * 1024 * 2;
constexpr size_t O_WXV = O_WXK + 1024ull * 1024 * 2;
constexpr size_t O_WXO = O_WXV + 1024ull * 1024 * 2;
constexpr size_t O_WGU = O_WXO + 1024ull * 1024 * 2;
constexpr size_t O_WD = O_WGU + 5632ull * 1024 * 2;
constexpr size_t O_WGLU = O_WD + 1024ull * 2816 * 2;
constexpr size_t O_HB = O_WGLU + 512ull * 512 * 2;
constexpr size_t O_QK = O_HB + (size_t)T_ * 1024 * 2;
constexpr size_t O_SBUF = O_QK + (size_t)T_ * 4096 * 2;
constexpr size_t O_DCY = O_SBUF + 2048ull * 128 * 128 * 2;
constexpr size_t O_LOGF = O_DCY + 2048ull * 128 * 4;
constexpr size_t O_CUM = O_LOGF + (size_t)T_ * 8 * 4;
constexpr size_t O_S5E = O_CUM + (size_t)T_ * 8 * 4;
constexpr size_t O_MEMN = O_S5E + 2ull * 32 * 128 * 64 * 8;
constexpr size_t O_KXR = O_MEMN + 512ull * 1024 * 2;
constexpr size_t O_KXN = O_KXR + 512ull * 1024 * 4;
constexpr size_t O_VXT = O_KXN + 512ull * 1024 * 2;
constexpr size_t O_S5T = O_VXT + 512ull * 1024 * 2;
constexpr size_t O_YF = O_S5T + 32ull * 64 * 36 * 4;
constexpr size_t O_BAR = O_YF + (size_t)T_ * 512 * 2;
constexpr size_t O_GS = O_BAR + 256;
constexpr size_t O_END = O_GS + 256ull * 512 * 256;

struct Params {
  const float *x, *mem, *norm_mix, *w_in, *fox_fbias, *fox_qnorm, *fox_knorm, *s5_a_re, *s5_a_im, *s5_b_re, *s5_b_im,
      *s5_c_re, *s5_c_im, *s5_d, *s5_log_dt, *s5_w_glu, *s5_b_glu, *hg_lb, *hg_onorm, *w_branch, *w_out, *norm_x,
      *norm_mem, *xq, *xk, *xv, *xo, *x_qnorm, *x_knorm, *norm_ffn, *w_gate_up, *w_down;
  float* out;
  unsigned char* ws;
};

DI unsigned pk2(float a, float b) {
  f32x2 v = {a, b};
  hbf2 r = __builtin_convertvector(v, hbf2);
  return __builtin_bit_cast(unsigned, r);
}
DI bf16_t f2bf(float a) { return (bf16_t)(pk2(a, 0.f) & 0xffffu); }
DI float bf2f(bf16_t v) { return __uint_as_float((unsigned)v << 16); }
DI float bflo(unsigned u) { return __uint_as_float(u << 16); }
DI float bfhi(unsigned u) { return __uint_as_float(u & 0xffff0000u); }
DI float wave_sum(float v) {
  v += __shfl_xor(v, 32, 64); v += __shfl_xor(v, 16, 64); v += __shfl_xor(v, 8, 64);
  v += __shfl_xor(v, 4, 64); v += __shfl_xor(v, 2, 64); v += __shfl_xor(v, 1, 64);
  return v;
}
DI float sigmoidf_(float x) { return __builtin_amdgcn_rcpf(1.f + __expf(-x)); }
DI float ex2(float x) { return __builtin_amdgcn_exp2f(x); }
DI f32x4 zero4() { return (f32x4){0.f, 0.f, 0.f, 0.f}; }
DI void store_bf4(bf16_t* p, f32x4 v) { u32x2 w; w.x = pk2(v[0], v[1]); w.y = pk2(v[2], v[3]); *(u32x2*)p = w; }
DI bf16x8 pack8(f32x4 a, f32x4 b) {
  u32x4 w; w.x = pk2(a[0], a[1]); w.y = pk2(a[2], a[3]); w.z = pk2(b[0], b[1]); w.w = pk2(b[2], b[3]);
  return __builtin_bit_cast(bf16x8, w);
}
DI bf16x8 cat4(bf16x4 lo, bf16x4 hi) { return __builtin_shufflevector(lo, hi, 0, 1, 2, 3, 4, 5, 6, 7); }

constexpr int LDT = 72;
template <int NI>
DI void gemm_core(const bf16_t* __restrict__ A, int lda, const bf16_t* __restrict__ Bt, int ldb, int K,
                  f32x4 (&acc)[4][NI], unsigned char* smem, int tid) {
  constexpr int BN = 32 * NI;
  constexpr int NB = BN / 32;
  bf16_t* sA = (bf16_t*)smem;
  bf16_t* sB = sA + 2 * 128 * LDT;
  const int lane = tid & 63, wave = tid >> 6, wr = wave >> 1, wc = wave & 1, fr = lane & 15, fq = lane >> 4;
  const int lrow = tid >> 3, lkc = (tid & 7) * 8;
  u32x4 ra[4], rb[NB];
  const int nk = K >> 6;
  const bf16_t* ga = A + (size_t)lrow * lda + lkc;
  const bf16_t* gb = Bt + (size_t)lrow * ldb + lkc;
#pragma unroll
  for (int i = 0; i < 4; ++i) ra[i] = *(const u32x4*)(ga + (size_t)(32 * i) * lda);
#pragma unroll
  for (int i = 0; i < NB; ++i) rb[i] = *(const u32x4*)(gb + (size_t)(32 * i) * ldb);
#pragma unroll
  for (int i = 0; i < 4; ++i) *(u32x4*)(sA + (lrow + 32 * i) * LDT + lkc) = ra[i];
#pragma unroll
  for (int i = 0; i < NB; ++i) *(u32x4*)(sB + (lrow + 32 * i) * LDT + lkc) = rb[i];
  __syncthreads();
  for (int kt = 0; kt < nk; ++kt) {
    const int buf = kt & 1;
    if (kt + 1 < nk) {
#pragma unroll
      for (int i = 0; i < 4; ++i) ra[i] = *(const u32x4*)(ga + (size_t)(32 * i) * lda + (kt + 1) * 64);
#pragma unroll
      for (int i = 0; i < NB; ++i) rb[i] = *(const u32x4*)(gb + (size_t)(32 * i) * ldb + (kt + 1) * 64);
    }
    const bf16_t* pa = sA + buf * 128 * LDT + (wr * 64 + fr) * LDT + fq * 8;
    const bf16_t* pb = sB + buf * BN * LDT + (wc * 16 * NI + fr) * LDT + fq * 8;
#pragma unroll
    for (int kk = 0; kk < 2; ++kk) {
      bf16x8 af[4], bfr[NI];
#pragma unroll
      for (int i = 0; i < 4; ++i) af[i] = *(const bf16x8*)(pa + i * 16 * LDT + kk * 32);
#pragma unroll
      for (int i = 0; i < NI; ++i) bfr[i] = *(const bf16x8*)(pb + i * 16 * LDT + kk * 32);
#pragma unroll
      for (int mi = 0; mi < 4; ++mi)
#pragma unroll
        for (int ni = 0; ni < NI; ++ni) acc[mi][ni] = MFMA16(bfr[ni], af[mi], acc[mi][ni]);
    }
    if (kt + 1 < nk) {
      const int nb = buf ^ 1;
#pragma unroll
      for (int i = 0; i < 4; ++i) *(u32x4*)(sA + nb * 128 * LDT + (lrow + 32 * i) * LDT + lkc) = ra[i];
#pragma unroll
      for (int i = 0; i < NB; ++i) *(u32x4*)(sB + nb * BN * LDT + (lrow + 32 * i) * LDT + lkc) = rb[i];
    }
    __syncthreads();
  }
}
DI void gemm_core8(const bf16_t* __restrict__ A, int lda, const bf16_t* __restrict__ Bt, int ldb, int K,
                   f32x4 (&acc)[4][8], unsigned char* smem, int t8) {
  bf16_t* sA = (bf16_t*)smem;
  bf16_t* sB = sA + 2 * 256 * LDT;
  const int lane = t8 & 63, wave = t8 >> 6, wr = wave >> 1, wc = wave & 1, fr = lane & 15, fq = lane >> 4;
  const int lrow = t8 >> 3, lkc = (t8 & 7) * 8;
  u32x4 ra[4], rb[4];
  const int nk = K >> 6;
  const bf16_t* ga = A + (size_t)lrow * lda + lkc;
  const bf16_t* gb = Bt + (size_t)lrow * ldb + lkc;
#pragma unroll
  for (int i = 0; i < 4; ++i) { ra[i] = *(const u32x4*)(ga + (size_t)(64 * i) * lda); rb[i] = *(const u32x4*)(gb + (size_t)(64 * i) * ldb); }
#pragma unroll
  for (int i = 0; i < 4; ++i) { *(u32x4*)(sA + (lrow + 64 * i) * LDT + lkc) = ra[i]; *(u32x4*)(sB + (lrow + 64 * i) * LDT + lkc) = rb[i]; }
  __syncthreads();
  for (int kt = 0; kt < nk; ++kt) {
    const int buf = kt & 1;
    if (kt + 1 < nk) {
#pragma unroll
      for (int i = 0; i < 4; ++i) { ra[i] = *(const u32x4*)(ga + (size_t)(64 * i) * lda + (kt + 1) * 64); rb[i] = *(const u32x4*)(gb + (size_t)(64 * i) * ldb + (kt + 1) * 64); }
    }
    const bf16_t* pa = sA + buf * 256 * LDT + (wr * 64 + fr) * LDT + fq * 8;
    const bf16_t* pb = sB + buf * 256 * LDT + (wc * 128 + fr) * LDT + fq * 8;
#pragma unroll
    for (int kk = 0; kk < 2; ++kk) {
      bf16x8 af[4];
#pragma unroll
      for (int i = 0; i < 4; ++i) af[i] = *(const bf16x8*)(pa + i * 16 * LDT + kk * 32);
#pragma unroll
      for (int nh = 0; nh < 2; ++nh) {
        bf16x8 bfr[4];
#pragma unroll
        for (int i = 0; i < 4; ++i) bfr[i] = *(const bf16x8*)(pb + (nh * 4 + i) * 16 * LDT + kk * 32);
#pragma unroll
        for (int mi = 0; mi < 4; ++mi)
#pragma unroll
          for (int ni = 0; ni < 4; ++ni) acc[mi][nh * 4 + ni] = MFMA16(bfr[ni], af[mi], acc[mi][nh * 4 + ni]);
      }
    }
    if (kt + 1 < nk) {
      const int nb = buf ^ 1;
#pragma unroll
      for (int i = 0; i < 4; ++i) { *(u32x4*)(sA + nb * 256 * LDT + (lrow + 64 * i) * LDT + lkc) = ra[i]; *(u32x4*)(sB + nb * 256 * LDT + (lrow + 64 * i) * LDT + lkc) = rb[i]; }
    }
    __syncthreads();
  }
}
DI void gemm_core8b(const bf16_t* __restrict__ A, int lda, const bf16_t* __restrict__ Bt, int ldb, int K,
                    f32x4 (&acc)[4][4], unsigned char* smem, int t8) {
  bf16_t* sA = (bf16_t*)smem;
  bf16_t* sB = sA + 2 * 256 * LDT;
  const int lane = t8 & 63, wave = t8 >> 6, wr = wave >> 1, wc = wave & 1, fr = lane & 15, fq = lane >> 4;
  const int lrow = t8 >> 3, lkc = (t8 & 7) * 8;
  u32x4 ra[4], rb[2];
  const int nk = K >> 6;
  const bf16_t* ga = A + (size_t)lrow * lda + lkc;
  const bf16_t* gb = Bt + (size_t)lrow * ldb + lkc;
#pragma unroll
  for (int i = 0; i < 4; ++i) ra[i] = *(const u32x4*)(ga + (size_t)(64 * i) * lda);
#pragma unroll
  for (int i = 0; i < 2; ++i) rb[i] = *(const u32x4*)(gb + (size_t)(64 * i) * ldb);
#pragma unroll
  for (int i = 0; i < 4; ++i) *(u32x4*)(sA + (lrow + 64 * i) * LDT + lkc) = ra[i];
#pragma unroll
  for (int i = 0; i < 2; ++i) *(u32x4*)(sB + (lrow + 64 * i) * LDT + lkc) = rb[i];
  __syncthreads();
  for (int kt = 0; kt < nk; ++kt) {
    const int buf = kt & 1;
    if (kt + 1 < nk) {
#pragma unroll
      for (int i = 0; i < 4; ++i) ra[i] = *(const u32x4*)(ga + (size_t)(64 * i) * lda + (kt + 1) * 64);
#pragma unroll
      for (int i = 0; i < 2; ++i) rb[i] = *(const u32x4*)(gb + (size_t)(64 * i) * ldb + (kt + 1) * 64);
    }
    const bf16_t* pa = sA + buf * 256 * LDT + (wr * 64 + fr) * LDT + fq * 8;
    const bf16_t* pb = sB + buf * 128 * LDT + (wc * 64 + fr) * LDT + fq * 8;
#pragma unroll
    for (int kk = 0; kk < 2; ++kk) {
      bf16x8 af[4];
#pragma unroll
      for (int i = 0; i < 4; ++i) af[i] = *(const bf16x8*)(pa + i * 16 * LDT + kk * 32);
#pragma unroll
      for (int nh = 0; nh < 2; ++nh) {
        bf16x8 bfr[2];
#pragma unroll
        for (int i = 0; i < 2; ++i) bfr[i] = *(const bf16x8*)(pb + (nh * 2 + i) * 16 * LDT + kk * 32);
#pragma unroll
        for (int mi = 0; mi < 4; ++mi)
#pragma unroll
          for (int ni = 0; ni < 2; ++ni) acc[mi][nh * 2 + ni] = MFMA16(bfr[ni], af[mi], acc[mi][nh * 2 + ni]);
      }
    }
    if (kt + 1 < nk) {
      const int nb = buf ^ 1;
#pragma unroll
      for (int i = 0; i < 4; ++i) *(u32x4*)(sA + nb * 256 * LDT + (lrow + 64 * i) * LDT + lkc) = ra[i];
#pragma unroll
      for (int i = 0; i < 2; ++i) *(u32x4*)(sB + nb * 128 * LDT + (lrow + 64 * i) * LDT + lkc) = rb[i];
    }
    __syncthreads();
  }
}
DI int lds_byte8(int r, int c) { const int st = (r >> 4) * 2 + (c >> 5), rr = r & 15, cc = c & 31, ob = rr * 64 + cc * 2; return st * 1024 + (ob ^ (((ob >> 9) & 1) << 5)); }
DI void stage_rc8(int b, int& R, int& C) { const int st = b / 1024, sb = b % 1024, swz = sb ^ (((sb >> 9) & 1) << 5); R = (st >> 1) * 16 + swz / 64; C = (st & 1) * 32 + (swz % 64) / 2; }
DI void gemm8p(const bf16_t* __restrict__ A, int lda, const bf16_t* __restrict__ Bt, int ldb, int K,
               f32x4 (&acc)[2][2][4][2], unsigned char* smem, int t8) {
  const int wid = t8 >> 6, lane = t8 & 63, wr = wid >> 2, wc = wid & 3, fr = lane & 15, fq = lane >> 4;
  const int frag = (fr * 64 + fq * 16) ^ ((fr >> 3) << 5);
  const char* pA = (const char*)smem + wr * 8192 + frag;
  const char* pB = (const char*)smem + 4 * 16384 + wc * 4096 + frag;
  const int swz = ((lane * 16) ^ ((lane >> 5) << 5));
  const int R0 = (wid >> 1) * 16 + (swz >> 6), C0 = (wid & 1) * 32 + ((swz & 63) >> 1);
  unsigned offA = (unsigned)(R0 * lda + C0), offB = (unsigned)(R0 * ldb + C0);
  char* pS = (char*)smem + t8 * 16;
#define G8_STAGE_A(bh, half, kt) do { asm volatile("" : "+v"(offA)); \
    _Pragma("unroll") for (int _i = 0; _i < 2; ++_i) \
      __builtin_amdgcn_global_load_lds((const unsigned*)(A + (offA + (unsigned)(((half) * 128 + _i * 64) * lda + (kt) * 64))), \
        (unsigned*)(pS + (bh) * 16384 + _i * 8192), 16, 0, 0); } while (0)
#define G8_STAGE_B(bh, half, kt) do { asm volatile("" : "+v"(offB)); \
    _Pragma("unroll") for (int _i = 0; _i < 2; ++_i) \
      __builtin_amdgcn_global_load_lds((const unsigned*)(Bt + (offB + (unsigned)(((half) * 128 + _i * 64) * ldb + (kt) * 64))), \
        (unsigned*)(pS + (4 + (bh)) * 16384 + _i * 8192), 16, 0, 0); } while (0)
#define G8_LDA(dst, bh) _Pragma("unroll") for (int m = 0; m < 4; ++m) _Pragma("unroll") for (int k = 0; k < 2; ++k) \
    dst[m][k] = *reinterpret_cast<const bf16x8*>(pA + (bh) * 16384 + (m * 2 + k) * 1024)
#define G8_LDB(dst, bh) _Pragma("unroll") for (int n = 0; n < 2; ++n) _Pragma("unroll") for (int k = 0; k < 2; ++k) \
    dst[n][k] = *reinterpret_cast<const bf16x8*>(pB + (bh) * 16384 + (n * 2 + k) * 1024)
#define G8_MMA(ai, bj, At_, Bt_) do { __builtin_amdgcn_s_setprio(1); \
    _Pragma("unroll") for (int m = 0; m < 4; ++m) _Pragma("unroll") for (int n = 0; n < 2; ++n) _Pragma("unroll") for (int k = 0; k < 2; ++k) \
      acc[ai][bj][m][n] = MFMA16(Bt_[n][k], At_[m][k], acc[ai][bj][m][n]); \
    __builtin_amdgcn_s_setprio(0); } while (0)
#define G8_WAIT_V(n) asm volatile("s_waitcnt vmcnt(" #n ")" ::: "memory")
#define G8_WAIT_L(n) asm volatile("s_waitcnt lgkmcnt(" #n ")" ::: "memory")
#define G8_BAR __builtin_amdgcn_s_barrier()
#define G8_SCHED __builtin_amdgcn_sched_barrier(0)
  bf16x8 At[4][2], B0[2][2], B1[2][2];
  const int nt = K / 64;
  G8_WAIT_V(0);
  G8_STAGE_B(0, 0, 0); G8_STAGE_A(0, 0, 0);
  G8_STAGE_B(1, 1, 0); G8_STAGE_A(1, 1, 0);
  if (wr == 1) G8_BAR;
  G8_WAIT_V(4); G8_BAR;
  G8_STAGE_B(2, 0, 1); G8_STAGE_A(2, 0, 1); G8_STAGE_B(3, 1, 1);
  G8_WAIT_V(6); G8_BAR;
  for (int t = 0; t < nt - 2; t += 2) {
    G8_LDB(B0, 0); G8_SCHED; G8_LDA(At, 0); G8_STAGE_A(3, 1, t + 1);
    G8_WAIT_L(8); G8_BAR; G8_WAIT_L(0); G8_MMA(0, 0, At, B0); G8_BAR; G8_SCHED;
    G8_LDB(B1, 1); G8_STAGE_B(0, 0, t + 2);
    G8_BAR; G8_WAIT_L(0); G8_MMA(0, 1, At, B1); G8_BAR;
    G8_LDA(At, 1); G8_STAGE_A(0, 0, t + 2);
    G8_BAR; G8_WAIT_L(0); G8_MMA(1, 0, At, B0); G8_BAR; G8_SCHED;
    G8_STAGE_B(1, 1, t + 2);
    G8_WAIT_V(6); G8_BAR; G8_MMA(1, 1, At, B1); G8_BAR;
    G8_LDB(B0, 2); G8_SCHED; G8_LDA(At, 2); G8_STAGE_A(1, 1, t + 2);
    G8_WAIT_L(8); G8_BAR; G8_WAIT_L(0); G8_MMA(0, 0, At, B0); G8_BAR; G8_SCHED;
    G8_LDB(B1, 3); G8_STAGE_B(2, 0, t + 3);
    G8_BAR; G8_WAIT_L(0); G8_MMA(0, 1, At, B1); G8_BAR;
    G8_LDA(At, 3); G8_STAGE_A(2, 0, t + 3);
    G8_BAR; G8_WAIT_L(0); G8_MMA(1, 0, At, B0); G8_BAR; G8_SCHED;
    G8_STAGE_B(3, 1, t + 3);
    G8_WAIT_V(6); G8_BAR; G8_MMA(1, 1, At, B1); G8_BAR;
  }
  { G8_LDB(B0, 0); G8_LDA(At, 0); G8_STAGE_A(3, 1, nt - 1);
    G8_BAR; G8_WAIT_L(0); G8_MMA(0, 0, At, B0); G8_BAR;
    G8_LDB(B1, 1); G8_BAR; G8_WAIT_L(0); G8_MMA(0, 1, At, B1); G8_BAR;
    G8_LDA(At, 1); G8_WAIT_V(4); G8_BAR; G8_WAIT_L(0); G8_MMA(1, 0, At, B0); G8_MMA(1, 1, At, B1); G8_BAR; }
  { G8_LDB(B0, 2); G8_LDA(At, 2); G8_WAIT_V(2); G8_BAR; G8_WAIT_L(0); G8_MMA(0, 0, At, B0); G8_BAR;
    G8_LDB(B1, 3); G8_WAIT_V(0); G8_BAR; G8_WAIT_L(0); G8_MMA(0, 1, At, B1); G8_BAR;
    G8_LDA(At, 3); G8_BAR; G8_WAIT_L(0); G8_MMA(1, 0, At, B0); G8_MMA(1, 1, At, B1); G8_BAR; }
  if (wr == 0) G8_BAR;
}
DI void xcd_tile(int it, int WG, int NWG, int NT, int& mt, int& nt) {
  int L = it;
  if (NWG == 256) L = (it - WG) + (WG & 7) * 32 + (WG >> 3);
  const int g = L / (8 * NT), idx = L - g * (8 * NT);
  mt = g * 8 + (idx & 7); nt = idx >> 3;
}
DI void zero_acc8p(f32x4 (&acc)[2][2][4][2]) {
#pragma unroll
  for (int a = 0; a < 2; ++a)
#pragma unroll
    for (int b = 0; b < 2; ++b)
#pragma unroll
      for (int m = 0; m < 4; ++m)
#pragma unroll
        for (int n = 0; n < 2; ++n) acc[a][b][m][n] = zero4();
}
DI void zero_acc8(f32x4 (&acc)[4][8]) {
#pragma unroll
  for (int i = 0; i < 4; ++i)
#pragma unroll
    for (int j = 0; j < 8; ++j) acc[i][j] = zero4();
}
template <int NI>
DI void zero_acc(f32x4 (&acc)[4][NI]) {
#pragma unroll
  for (int i = 0; i < 4; ++i)
#pragma unroll
    for (int j = 0; j < NI; ++j) acc[i][j] = zero4();
}

DI int conv_col(int n, int mode, int base) {
  if (mode == 0) return n + base;
  if (mode == 1) return n < 1536 ? n : n + 8;
  const int g = n >> 5, s = (n >> 4) & 1, i = n & 15;
  return s * DFF + g * 16 + i;
}
DI void conv_tile(const float* __restrict__ src, int ld, bf16_t* __restrict__ dst, int Kd, int k0, int n0, int mode, int base,
                  bf16_t* tile, int tid) {
  const int n4 = (tid & 15) * 4, kr = tid >> 4;
  const int col = conv_col(n0 + n4, mode, base);
#pragma unroll
  for (int i = 0; i < 4; ++i) {
    const int k = kr + 16 * i;
    const f32x4 v = *(const f32x4*)(src + (size_t)(k0 + k) * ld + col);
    tile[(n4 + 0) * LDT + k] = f2bf(v[0]);
    tile[(n4 + 1) * LDT + k] = f2bf(v[1]);
    tile[(n4 + 2) * LDT + k] = f2bf(v[2]);
    tile[(n4 + 3) * LDT + k] = f2bf(v[3]);
  }
  __syncthreads();
  const int kc = (tid & 7) * 8, nr = tid >> 3;
#pragma unroll
  for (int i = 0; i < 2; ++i) {
    const int n = nr + 32 * i;
    *(u32x4*)(dst + (size_t)(n0 + n) * Kd + k0 + kc) = *(const u32x4*)(tile + n * LDT + kc);
  }
  __syncthreads();
}

DI void conv_item(const Params& p, int l, int it, bf16_t* tile, int tid) {
  unsigned char* ws = p.ws;
  if (it < 1024) { conv_tile(p.w_in + (size_t)l * D_ * INC, INC, (bf16_t*)(ws + O_WP), 1024, (it & 15) * 64, (it >> 4) * 64, 1, 0, tile, tid); return; }
  it -= 1024;
  if (it < 768) { conv_tile(p.w_in + (size_t)l * D_ * INC, INC, (bf16_t*)(ws + O_WG), 1024, (it & 15) * 64, (it >> 4) * 64, 0, 4104, tile, tid); return; }
  it -= 768;
  if (it < 384) { const int b = it >> 7, r = it & 127;
    conv_tile(p.w_branch + (size_t)l * 1536 * 1024 + (size_t)b * 512 * 1024, 1024, (bf16_t*)(ws + O_WBR) + (size_t)b * 1024 * 512, 512, (r & 7) * 64, (r >> 3) * 64, 0, 0, tile, tid); return; }
  it -= 384;
  if (it < 1280) { const int w = it >> 8, r = it & 255;
    const float* src = (w == 0 ? p.w_out : w == 1 ? p.xq : w == 2 ? p.xk : w == 3 ? p.xv : p.xo) + (size_t)l * 1024 * 1024;
    bf16_t* dst = (bf16_t*)(ws + (w == 0 ? O_WOUT : w == 1 ? O_WXQ : w == 2 ? O_WXK : w == 3 ? O_WXV : O_WXO));
    conv_tile(src, 1024, dst, 1024, (r & 15) * 64, (r >> 4) * 64, 0, 0, tile, tid); return; }
  it -= 1280;
  if (it < 1408) { conv_tile(p.w_gate_up + (size_t)l * 1024 * 5632, 5632, (bf16_t*)(ws + O_WGU), 1024, (it & 15) * 64, (it >> 4) * 64, 2, 0, tile, tid); return; }
  it -= 1408;
  if (it < 704) { const int kt = it % 44, nt = it / 44;
    conv_tile(p.w_down + (size_t)l * DFF * 1024, 1024, (bf16_t*)(ws + O_WD), DFF, kt * 64, nt * 64, 0, 0, tile, tid); return; }
  it -= 704;
  conv_tile(p.s5_w_glu + (size_t)l * 512 * 512, 512, (bf16_t*)(ws + O_WGLU), 512, (it & 7) * 64, (it >> 3) * 64, 0, 0, tile, tid);
}
constexpr int N_CONV = 1024 + 768 + 384 + 1280 + 1408 + 704 + 64;

DI void norm_item(const float* __restrict__ X, const float* __restrict__ gain, bf16_t* __restrict__ Hout, int row0,
                  const float* wfft, float* __restrict__ logf_out, const float* __restrict__ fbias, int tid) {
  const int lane = tid & 63, wave = tid >> 6;
  f32x4 g4[4];
#pragma unroll
  for (int i = 0; i < 4; ++i) g4[i] = *(const f32x4*)(gain + i * 256 + lane * 4);
  for (int rr = 0; rr < 8; ++rr) {
    const int row = row0 + wave * 8 + rr;
    const float* xr = X + (size_t)row * 1024;
    f32x4 v[4];
    float ss = 0.f;
#pragma unroll
    for (int i = 0; i < 4; ++i) {
      v[i] = *(const f32x4*)(xr + i * 256 + lane * 4);
      ss += v[i][0] * v[i][0] + v[i][1] * v[i][1] + v[i][2] * v[i][2] + v[i][3] * v[i][3];
    }
    ss = wave_sum(ss);
    const float rs = rsqrtf(ss * (1.f / 1024.f) + EPS);
#pragma unroll
    for (int i = 0; i < 4; ++i) {
      v[i] = v[i] * rs * g4[i];
      store_bf4(Hout + (size_t)row * 1024 + i * 256 + lane * 4, v[i]);
    }
    if (wfft) {
      float mine = 0.f;
#pragma unroll
      for (int j = 0; j < 8; ++j) {
        float a = 0.f;
#pragma unroll
        for (int i = 0; i < 4; ++i) {
          const f32x4 w = *(const f32x4*)(wfft + j * 1024 + i * 256 + lane * 4);
          a += v[i][0] * w[0] + v[i][1] * w[1] + v[i][2] * w[2] + v[i][3] * w[3];
        }
        a = wave_sum(a);
        mine = (lane == j) ? a : mine;
      }
      if (lane < 8) {
        const float xv = mine + fbias[lane];
        logf_out[(size_t)row * 8 + lane] = fminf(xv, 0.f) - __logf(1.f + __expf(-fabsf(xv)));
      }
    }
  }
}

DI void cumsum_item(const Params& p, int bh, unsigned char* smem, int tid) {
  const float* logf = (const float*)(p.ws + O_LOGF);
  float* cum = (float*)(p.ws + O_CUM);
  float* part = (float*)smem;
  const int b = bh >> 3, h = bh & 7;
  const float* src = logf + ((size_t)b * S_ + tid * 64) * 8 + h;
  float s = 0.f;
  for (int j = 0; j < 64; ++j) s += src[j * 8];
  part[tid] = s;
  __syncthreads();
  float pre = 0.f;
  for (int j = 0; j < tid; ++j) pre += part[j];
  float* dst = cum + (size_t)bh * S_ + tid * 64;
  for (int j = 0; j < 64; ++j) { pre += src[j * 8]; dst[j] = pre * LOG2E; }
  __syncthreads();
}

constexpr int LDK = 72;
DI void fox_item(const Params& p, int fox_l, int idx, unsigned char* smem, int tid) {
  bf16_t* QK = (bf16_t*)(p.ws + O_QK);
  const int bh = idx & 15, qt = 63 - (idx >> 4);
  const int b = bh >> 3, h = bh & 7;
  const int lane = tid & 63, wave = tid >> 6, fr = lane & 15, fq = lane >> 4;
  const float* cum = (const float*)(p.ws + O_CUM) + (size_t)bh * S_;
  const size_t rowbase = (size_t)b * S_;
  const int q0 = qt * 256 + wave * 32;
  bf16_t* sK = (bf16_t*)smem;
  bf16_t* sV = sK + 2 * 64 * LDK;
  float* sC = (float*)(sV + 2 * 64 * LDK);
  int* sF = (int*)(sC + 128);
  float qkb;
  {
    float gq = fabsf(p.fox_qnorm[fox_l * 64 + lane]), gk = fabsf(p.fox_knorm[fox_l * 64 + lane]);
#pragma unroll
    for (int mm = 32; mm >= 1; mm >>= 1) { gq = fmaxf(gq, __shfl_xor(gq, mm, 64)); gk = fmaxf(gk, __shfl_xor(gk, mm, 64)); }
    qkb = 8.f * LOG2E * gq * gk * 1.02f + 40.f;
  }
  bool wdone = false;
  bf16x8 qf[2][2];
  float cq[2];
#pragma unroll
  for (int f = 0; f < 2; ++f) {
    const int q = q0 + f * 16 + fr;
    const bf16_t* qp = QK + (rowbase + q) * 4096 + h * 64;
    qf[f][0] = *(const bf16x8*)(qp + fq * 8);
    qf[f][1] = *(const bf16x8*)(qp + 32 + fq * 8);
    cq[f] = cum[q];
  }
  f32x4 o[4][2];
#pragma unroll
  for (int d = 0; d < 4; ++d) { o[d][0] = zero4(); o[d][1] = zero4(); }
  float m[2] = {-1e30f, -1e30f}, ls[2] = {0.f, 0.f};
  const int ntiles = (qt + 1) * 4;
  const int kkey = tid >> 3, kdc = (tid & 7) * 8;
  const int vkey = tid & 63, vdc = (tid >> 6) * 8;
  const bf16_t* gk = QK + (rowbase + kkey) * 4096 + 512 + h * 64 + kdc;
  const bf16_t* gv = QK + (rowbase + vkey) * 4096 + 1024 + h * 64 + vdc;
  u32x4 rk0[1], rv0[1], rk1[1], rv1[1];
  float rc0 = 0.f, rc1 = 0.f;
  auto gload = [&](int t, u32x4 (&rk)[1], u32x4 (&rv)[1], float& rc) {
    const size_t off = (size_t)t * 64 * 4096;
    rk[0] = *(const u32x4*)(gk + off);
    rv[0] = *(const u32x4*)(gv + off);
    if (tid < 64) rc = cum[t * 64 + tid];
  };
  auto sstore = [&](int buf, const u32x4 (&rk)[1], const u32x4 (&rv)[1], float rc) {
    {
      *(u32x4*)(sK + buf * 64 * LDK + kkey * LDK + kdc) = rk[0];
      bf16_t* vp = sV + buf * 64 * LDK + vdc * LDK + vkey;
      const u32x4 w = rv[0];
      vp[0 * LDK] = (bf16_t)(w.x & 0xffff); vp[1 * LDK] = (bf16_t)(w.x >> 16);
      vp[2 * LDK] = (bf16_t)(w.y & 0xffff); vp[3 * LDK] = (bf16_t)(w.y >> 16);
      vp[4 * LDK] = (bf16_t)(w.z & 0xffff); vp[5 * LDK] = (bf16_t)(w.z >> 16);
      vp[6 * LDK] = (bf16_t)(w.w & 0xffff); vp[7 * LDK] = (bf16_t)(w.w >> 16);
    }
    if (tid < 64) sC[buf * 64 + tid] = rc;
  };
  auto compute = [&](int t, int buf) {
    const int k0 = t * 64;
    if (!wdone && k0 <= q0 + 31) {
      const float cnew = sC[buf * 64 + 63];
      const bool prune = (qkb + cq[0] - cnew < m[0]) && (qkb + cq[1] - cnew < m[1]);
      if (__builtin_amdgcn_ballot_w64(!prune) == 0ull) wdone = true;
    }
    if (!wdone && k0 <= q0 + 31) {
      const bf16_t* bK = sK + buf * 64 * LDK;
      const bf16_t* bV = sV + buf * 64 * LDK;
      const float* bC = sC + buf * 64;
      f32x4 s[4][2];
#pragma unroll
      for (int kf = 0; kf < 4; ++kf) {
        s[kf][0] = (f32x4){cq[0], cq[0], cq[0], cq[0]};
        s[kf][1] = (f32x4){cq[1], cq[1], cq[1], cq[1]};
      }
#pragma unroll
      for (int kk = 0; kk < 2; ++kk)
#pragma unroll
        for (int kf = 0; kf < 4; ++kf) {
          const bf16x8 a = *(const bf16x8*)(bK + (kf * 16 + fr) * LDK + kk * 32 + fq * 8);
          s[kf][0] = MFMA16(a, qf[0][kk], s[kf][0]);
          s[kf][1] = MFMA16(a, qf[1][kk], s[kf][1]);
        }
#pragma unroll
      for (int kf = 0; kf < 4; ++kf) {
        const f32x4 ck = *(const f32x4*)(bC + kf * 16 + fq * 4);
        s[kf][0] -= ck; s[kf][1] -= ck;
      }
      if (k0 + 63 > q0) {
#pragma unroll
        for (int kf = 0; kf < 4; ++kf)
#pragma unroll
          for (int f = 0; f < 2; ++f)
#pragma unroll
            for (int r = 0; r < 4; ++r) {
              const int key = k0 + kf * 16 + fq * 4 + r, q = q0 + f * 16 + fr;
              if (key > q) s[kf][f][r] = -1e30f;
            }
      }
#pragma unroll
      for (int f = 0; f < 2; ++f) {
        float mx = -1e30f;
#pragma unroll
        for (int kf = 0; kf < 4; ++kf)
#pragma unroll
          for (int r = 0; r < 4; ++r) mx = fmaxf(mx, s[kf][f][r]);
        mx = fmaxf(mx, __shfl_xor(mx, 16, 64));
        mx = fmaxf(mx, __shfl_xor(mx, 32, 64));
        const float mn = fmaxf(m[f], mx);
        const float alpha = ex2(m[f] - mn);
        m[f] = mn;
        float ps = 0.f;
#pragma unroll
        for (int kf = 0; kf < 4; ++kf)
#pragma unroll
          for (int r = 0; r < 4; ++r) { const float pv = ex2(s[kf][f][r] - mn); s[kf][f][r] = pv; ps += pv; }
        ls[f] = ls[f] * alpha + ps;
#pragma unroll
        for (int d = 0; d < 4; ++d) o[d][f] *= alpha;
      }
#pragma unroll
      for (int ss = 0; ss < 2; ++ss) {
        const bf16x8 pb0 = pack8(s[2 * ss][0], s[2 * ss + 1][0]);
        const bf16x8 pb1 = pack8(s[2 * ss][1], s[2 * ss + 1][1]);
#pragma unroll
        for (int d = 0; d < 4; ++d) {
          const bf16_t* vp = bV + (d * 16 + fr) * LDK + ss * 32 + fq * 4;
          const bf16x8 a = cat4(*(const bf16x4*)vp, *(const bf16x4*)(vp + 16));
          o[d][0] = MFMA16(a, pb0, o[d][0]);
          o[d][1] = MFMA16(a, pb1, o[d][1]);
        }
      }
    }
  };
  const int T = ntiles;
  gload(T - 1, rk0, rv0, rc0); sstore(0, rk0, rv0, rc0);
  gload(T - 2, rk0, rv0, rc0);
  if (T > 2) gload(T - 3, rk1, rv1, rc1);
  if (tid < 16) sF[tid] = 0;
  __syncthreads();
  int par = 0;
  for (int i = 0; i < T; i += 2) {
    if (i > 0) {
      int alldone = 1;
#pragma unroll
      for (int w = 0; w < 8; ++w) alldone &= sF[par * 8 + w];
      par ^= 1;
      if (alldone) break;
    }
    compute(T - 1 - i, 0);
    sstore(1, rk0, rv0, rc0);
    if (i + 3 < T) gload(T - 4 - i, rk0, rv0, rc0);
    __syncthreads();
    compute(T - 2 - i, 1);
    if (i + 2 < T) sstore(0, rk1, rv1, rc1);
    if (i + 4 < T) gload(T - 5 - i, rk1, rv1, rc1);
    if (lane == 0) sF[par * 8 + wave] = wdone ? 1 : 0;
    __syncthreads();
  }
  __syncthreads();
#pragma unroll
  for (int f = 0; f < 2; ++f) {
    float l = ls[f];
    l += __shfl_xor(l, 16, 64); l += __shfl_xor(l, 32, 64);
    const float inv = 1.f / l;
    const int q = q0 + f * 16 + fr;
    bf16_t* op = (bf16_t*)(p.ws + O_YF) + (rowbase + q) * 512 + h * 64 + fq * 4;
#pragma unroll
    for (int d = 0; d < 4; ++d) store_bf4(op + d * 16, o[d][f] * inv);
  }
}

DI float hg_lb_of(const Params& p, int l, int c) {
  float e[NL], tot = 0.f, part = 0.f;
  float mx = -1e30f;
#pragma unroll
  for (int j = 0; j < NL; ++j) { e[j] = p.hg_lb[j * 512 + c]; mx = fmaxf(mx, e[j]); }
#pragma unroll
  for (int j = 0; j < NL; ++j) { e[j] = __expf(e[j] - mx); tot += e[j]; part += (j >= 1 && j <= l) ? e[j] : 0.f; }
  return part / tot;
}
DI void hg_gate(float z, float lb, float& logf, float& key) {
  const float sg = sigmoidf_(z);
  const float f = lb + (1.f - lb) * sg;
  key = (1.f - lb) * (1.f - sg);
  const float lsg = fminf(z, 0.f) - __logf(1.f + __expf(-fabsf(z)));
  logf = (lb == 0.f) ? lsg : __logf(f);
}
constexpr int LDH = 136;
DI void hg1_item(const Params& p, int l, int ch, unsigned char* smem, int tid) {
  const bf16_t* QK = (const bf16_t*)(p.ws + O_QK);
  bf16_t* SB = (bf16_t*)(p.ws + O_SBUF) + (size_t)ch * 16384;
  float* DC = (float*)(p.ws + O_DCY) + (size_t)ch * 128;
  const int bhh = ch >> 8, c = ch & 255, b = bhh >> 2, h = bhh & 3;
  const size_t row0 = (size_t)b * S_ + c * 64;
  bf16_t* kT = (bf16_t*)smem;
  bf16_t* vT = kT + 128 * LDK;
  float* sums = (float*)(vT + 128 * LDK);
  const int k = tid & 127, th = tid >> 7;
  const float lb = hg_lb_of(p, l, h * 128 + k);
  float lf[32], ky[32];
  float loc = 0.f;
  const bf16_t* zf = QK + (row0 + th * 32) * 4096 + 5 * 512 + h * 128 + k;
#pragma unroll
  for (int j = 0; j < 32; ++j) {
    hg_gate(bf2f(zf[(size_t)j * 4096]), lb, lf[j], ky[j]);
    loc += lf[j];
  }
  sums[th * 128 + k] = loc;
  {
    const int s = tid & 63, vc = (tid >> 6) * 8;
#pragma unroll
    for (int i = 0; i < 4; ++i) {
      const u32x4 w = *(const u32x4*)(QK + (row0 + s) * 4096 + 6 * 512 + h * 128 + vc + 32 * i);
      bf16_t* vp = vT + (vc + 32 * i) * LDK + s;
      vp[0 * LDK] = (bf16_t)(w.x & 0xffff); vp[1 * LDK] = (bf16_t)(w.x >> 16);
      vp[2 * LDK] = (bf16_t)(w.y & 0xffff); vp[3 * LDK] = (bf16_t)(w.y >> 16);
      vp[4 * LDK] = (bf16_t)(w.z & 0xffff); vp[5 * LDK] = (bf16_t)(w.z >> 16);
      vp[6 * LDK] = (bf16_t)(w.w & 0xffff); vp[7 * LDK] = (bf16_t)(w.w >> 16);
    }
  }
  __syncthreads();
  const float s0 = sums[k], s1 = sums[128 + k];
  const float total = s0 + s1;
  float run = th ? s0 : 0.f;
#pragma unroll
  for (int j = 0; j < 32; ++j) {
    run += lf[j];
    kT[k * LDK + th * 32 + j] = f2bf(ky[j] * __expf(total - run));
  }
  if (th == 0) DC[k] = __expf(total);
  __syncthreads();
  const int lane = tid & 63, wave = tid >> 6, fr = lane & 15, fq = lane >> 4;
  f32x4 acc[2][8];
#pragma unroll
  for (int i = 0; i < 2; ++i)
#pragma unroll
    for (int j = 0; j < 8; ++j) acc[i][j] = zero4();
#pragma unroll
  for (int ss = 0; ss < 2; ++ss) {
    bf16x8 bk[2];
#pragma unroll
    for (int i = 0; i < 2; ++i) bk[i] = *(const bf16x8*)(kT + (wave * 32 + i * 16 + fr) * LDK + ss * 32 + fq * 8);
#pragma unroll
    for (int j = 0; j < 8; ++j) {
      const bf16x8 av = *(const bf16x8*)(vT + (j * 16 + fr) * LDK + ss * 32 + fq * 8);
#pragma unroll
      for (int i = 0; i < 2; ++i) acc[i][j] = MFMA16(bk[i], av, acc[i][j]);
    }
  }
#pragma unroll
  for (int i = 0; i < 2; ++i)
#pragma unroll
    for (int j = 0; j < 8; ++j) store_bf4(SB + (j * 16 + fr) * 128 + wave * 32 + i * 16 + fq * 4, acc[i][j]);
  __syncthreads();
}
DI void hg2_item(const Params& p, int item, int tid) {
  const int gid = item * 256 + tid;
  const int bhh = gid >> 13, rem = gid & 8191, v = rem >> 6, k2 = (rem & 63) * 2;
  bf16_t* SB = (bf16_t*)(p.ws + O_SBUF) + (size_t)bhh * 256 * 16384 + v * 128 + k2;
  const float* DC = (const float*)(p.ws + O_DCY) + (size_t)bhh * 256 * 128 + k2;
  float s0 = 0.f, s1 = 0.f;
  for (int c = 0; c < 256; c += 8) {
    unsigned tmp[8]; f32x2 dc[8];
#pragma unroll
    for (int u = 0; u < 8; ++u) { tmp[u] = *(const unsigned*)(SB + (size_t)(c + u) * 16384); dc[u] = *(const f32x2*)(DC + (c + u) * 128); }
#pragma unroll
    for (int u = 0; u < 8; ++u) {
      *(unsigned*)(SB + (size_t)(c + u) * 16384) = pk2(s0, s1);
      s0 = dc[u][0] * s0 + bflo(tmp[u]);
      s1 = dc[u][1] * s1 + bfhi(tmp[u]);
    }
  }
}
DI void hg3_item(const Params& p, int l, int ch, unsigned char* smem, int tid) {
  bf16_t* QK = (bf16_t*)(p.ws + O_QK);
  const bf16_t* SB = (const bf16_t*)(p.ws + O_SBUF) + (size_t)ch * 16384;
  const int bhh = ch >> 8, c = ch & 255, b = bhh >> 2, h = bhh & 3;
  const size_t row0 = (size_t)b * S_ + c * 64;
  bf16_t* qi = (bf16_t*)smem;
  bf16_t* qa = qi + 64 * LDH;
  bf16_t* ka = qa + 64 * LDH;
  bf16_t* vT = ka + 64 * LDH;
  float* sums = (float*)(vT + 128 * LDK);
  const int k = tid & 127, th = tid >> 7;
  const float lb = hg_lb_of(p, l, h * 128 + k);
  float lf[32], ky[32];
  float loc = 0.f;
  const bf16_t* zf = QK + (row0 + th * 32) * 4096 + 5 * 512 + h * 128 + k;
  const bf16_t* zq = QK + (row0 + th * 32) * 4096 + 4 * 512 + h * 128 + k;
#pragma unroll
  for (int j = 0; j < 32; ++j) {
    hg_gate(bf2f(zf[(size_t)j * 4096]), lb, lf[j], ky[j]);
    loc += lf[j];
  }
  if (th == 0) sums[k] = loc;
  {
    const int s = tid & 63, vc = (tid >> 6) * 8;
#pragma unroll
    for (int i = 0; i < 4; ++i) {
      const u32x4 w = *(const u32x4*)(QK + (row0 + s) * 4096 + 6 * 512 + h * 128 + vc + 32 * i);
      bf16_t* vp = vT + (vc + 32 * i) * LDK + s;
      vp[0 * LDK] = (bf16_t)(w.x & 0xffff); vp[1 * LDK] = (bf16_t)(w.x >> 16);
      vp[2 * LDK] = (bf16_t)(w.y & 0xffff); vp[3 * LDK] = (bf16_t)(w.y >> 16);
      vp[4 * LDK] = (bf16_t)(w.z & 0xffff); vp[5 * LDK] = (bf16_t)(w.z >> 16);
      vp[6 * LDK] = (bf16_t)(w.w & 0xffff); vp[7 * LDK] = (bf16_t)(w.w >> 16);
    }
  }
  __syncthreads();
  {
    const float bmid = sums[k];
    float run = th ? bmid : 0.f;
#pragma unroll
    for (int j = 0; j < 32; ++j) {
      run += lf[j];
      const float qz = bf2f(zq[(size_t)j * 4096]);
      const float qs = qz * sigmoidf_(qz);
      const int t = th * 32 + j;
      const float er = __expf(run - bmid);
      qi[t * LDH + k] = f2bf(qs * __expf(run));
      qa[t * LDH + k] = f2bf(qs * er);
      ka[t * LDH + k] = f2bf(ky[j] / er);
    }
  }
  __syncthreads();
  const int lane = tid & 63, wave = tid >> 6, fr = lane & 15, fq = lane >> 4;
  const int tcol = wave * 16 + fr;
  f32x4 sc[4];
#pragma unroll
  for (int i = 0; i < 4; ++i) sc[i] = zero4();
#pragma unroll
  for (int kk = 0; kk < 4; ++kk) {
    const bf16x8 bq = *(const bf16x8*)(qa + tcol * LDH + kk * 32 + fq * 8);
#pragma unroll
    for (int sf = 0; sf < 4; ++sf) {
      const bf16x8 a = *(const bf16x8*)(ka + (sf * 16 + fr) * LDH + kk * 32 + fq * 8);
      sc[sf] = MFMA16(a, bq, sc[sf]);
    }
  }
#pragma unroll
  for (int sf = 0; sf < 4; ++sf)
#pragma unroll
    for (int r = 0; r < 4; ++r) { const int s = sf * 16 + fq * 4 + r; if (s > tcol) sc[sf][r] = 0.f; }
  f32x4 o[8];
#pragma unroll
  for (int j = 0; j < 8; ++j) o[j] = zero4();
#pragma unroll
  for (int ss = 0; ss < 2; ++ss) {
    const bf16x8 pb = pack8(sc[2 * ss], sc[2 * ss + 1]);
#pragma unroll
    for (int j = 0; j < 8; ++j) {
      const bf16_t* vp = vT + (j * 16 + fr) * LDK + ss * 32 + fq * 4;
      const bf16x8 a = cat4(*(const bf16x4*)vp, *(const bf16x4*)(vp + 16));
      o[j] = MFMA16(a, pb, o[j]);
    }
  }
#pragma unroll
  for (int kk = 0; kk < 4; ++kk) {
    const bf16x8 bq = *(const bf16x8*)(qi + tcol * LDH + kk * 32 + fq * 8);
#pragma unroll
    for (int j = 0; j < 8; ++j) {
      const bf16x8 a = *(const bf16x8*)(SB + (j * 16 + fr) * 128 + kk * 32 + fq * 8);
      o[j] = MFMA16(a, bq, o[j]);
    }
  }
  float ss = 0.f;
#pragma unroll
  for (int j = 0; j < 8; ++j) ss += o[j][0] * o[j][0] + o[j][1] * o[j][1] + o[j][2] * o[j][2] + o[j][3] * o[j][3];
  ss += __shfl_xor(ss, 16, 64); ss += __shfl_xor(ss, 32, 64);
  const float rs = rsqrtf(ss * (1.f / 128.f) + EPS);
  const float* gn = p.hg_onorm + l * 128;
  const size_t row = row0 + tcol;
#pragma unroll
  for (int j = 0; j < 8; ++j) {
    const int v = j * 16 + fq * 4;
    const f32x4 g4 = *(const f32x4*)(gn + v);
    const u32x2 gw = *(const u32x2*)(QK + row * 4096 + 7 * 512 + h * 128 + v);
    f32x4 gg = {bflo(gw.x), bfhi(gw.x), bflo(gw.y), bfhi(gw.y)};
    f32x4 y;
#pragma unroll
    for (int r = 0; r < 4; ++r) y[r] = o[j][r] * rs * g4[r] * gg[r] * sigmoidf_(gg[r]);
    store_bf4(QK + row * 4096 + 4 * 512 + h * 128 + v, y);
  }
  __syncthreads();
}

struct S5c { float abr, abi; };
DI void s5_consts(const Params& p, int l, int g, int lp, float& abr, float& abi, float& cfr, float& cfi) {
  const float dt = __expf(p.s5_log_dt[l * 32 + g]);
  const float ar = p.s5_a_re[(l * 32 + g) * 64 + lp], ai = p.s5_a_im[(l * 32 + g) * 64 + lp];
  const float mag = __expf(dt * ar);
  const float x = dt * ai;
  const float kq = rintf(x * 0.636619772367581343f);
  float r = fmaf(-kq, 1.5707855225e+00f, x);
  r = fmaf(-kq, 1.0804334124e-05f, r);
  const float r2 = r * r;
  const float sp_ = r + r * r2 * (-1.6666667163e-01f + r2 * (8.3333337680e-03f + r2 * (-1.9841270114e-04f + r2 * 2.7557314297e-06f)));
  const float cp_ = 1.f - 0.5f * r2 + r2 * r2 * (4.1666667908e-02f + r2 * (-1.3888889225e-03f + r2 * (2.4801587642e-05f + r2 * -2.7557314297e-07f)));
  const int nq = ((int)kq) & 3;
  const float sn = (nq == 0) ? sp_ : (nq == 1) ? cp_ : (nq == 2) ? -sp_ : -cp_;
  const float cs = (nq == 0) ? cp_ : (nq == 1) ? -sp_ : (nq == 2) ? -cp_ : sp_;
  abr = mag * cs; abi = mag * sn;
  const float inv = 1.f / (ar * ar + ai * ai);
  const float nr = abr - 1.f, ni = abi;
  cfr = (nr * ar + ni * ai) * inv;
  cfi = (ni * ar - nr * ai) * inv;
}
DI void s5tab_item(const Params& p, int l, int item, int tid) {
  const int gid = item * 256 + tid;
  const int g = gid >> 6, lp = gid & 63;
  float abr, abi, cfr, cfi;
  s5_consts(p, l, g, lp, abr, abi, cfr, cfi);
  float* tb = (float*)(p.ws + O_S5T) + (size_t)gid * 36;
  const float* br = p.s5_b_re + ((size_t)(l * 32 + g) * 64 + lp) * 16;
  const float* bi = p.s5_b_im + ((size_t)(l * 32 + g) * 64 + lp) * 16;
  *(f32x4*)tb = (f32x4){abr, abi, 0.f, 0.f};
#pragma unroll
  for (int q = 0; q < 4; ++q) {
    const f32x4 r4 = *(const f32x4*)(br + q * 4), i4 = *(const f32x4*)(bi + q * 4);
    *(f32x4*)(tb + 4 + q * 4) = cfr * r4 - cfi * i4;
    *(f32x4*)(tb + 20 + q * 4) = cfr * i4 + cfi * r4;
  }
}
DI void s5_load(const Params& p, int g, int lane, float& abr, float& abi, float (&bbr)[16], float (&bbi)[16]) {
  const float* tb = (const float*)(p.ws + O_S5T) + (size_t)(g * 64 + lane) * 36;
  const f32x4 a = *(const f32x4*)tb;
  abr = a[0]; abi = a[1];
#pragma unroll
  for (int q = 0; q < 4; ++q) {
    const f32x4 r4 = *(const f32x4*)(tb + 4 + q * 4), i4 = *(const f32x4*)(tb + 20 + q * 4);
#pragma unroll
    for (int e = 0; e < 4; ++e) { bbr[q * 4 + e] = r4[e]; bbi[q * 4 + e] = i4[e]; }
  }
}
DI void s5a_item(const Params& p, int l, int item, unsigned char* smem, int tid) {
  const bf16_t* QK = (const bf16_t*)(p.ws + O_QK);
  f32x2* E = (f32x2*)(p.ws + O_S5E);
  const int lane = tid & 63, wave = tid >> 6;
  const int wi = item * 4 + wave;
  const int g = wi & 31, c = (wi >> 5) & 127, b = wi >> 12;
  float* us = (float*)smem + wave * 2048;
  float abr, abi;
  float bbr[16], bbi[16];
  s5_load(p, g, lane, abr, abi, bbr, bbi);
  const size_t row0 = (size_t)b * S_ + c * 128;
#pragma unroll
  for (int i = 0; i < 2; ++i) {
    const int t = lane + 64 * i;
    const bf16_t* up = QK + (row0 + t) * 4096 + 3 * 512 + g * 16;
    const u32x4 w0 = *(const u32x4*)up, w1 = *(const u32x4*)(up + 8);
    float* d = us + t * 16;
    *(f32x4*)(d + 0) = (f32x4){bflo(w0.x), bfhi(w0.x), bflo(w0.y), bfhi(w0.y)};
    *(f32x4*)(d + 4) = (f32x4){bflo(w0.z), bfhi(w0.z), bflo(w0.w), bfhi(w0.w)};
    *(f32x4*)(d + 8) = (f32x4){bflo(w1.x), bfhi(w1.x), bflo(w1.y), bfhi(w1.y)};
    *(f32x4*)(d + 12) = (f32x4){bflo(w1.z), bfhi(w1.z), bflo(w1.w), bfhi(w1.w)};
  }
  __syncthreads();
  float hr = 0.f, hi = 0.f;
  float ur[2][16];
#pragma unroll
  for (int i = 0; i < 2; ++i)
#pragma unroll
    for (int h = 0; h < 16; ++h) ur[i][h] = us[(lane + 64 * i) * 16 + h];
#pragma unroll
  for (int i = 0; i < 2; ++i) {
    for (int tt = 0; tt < 64; ++tt) {
      float dr = 0.f, di = 0.f;
#pragma unroll
      for (int h = 0; h < 16; ++h) {
        const float uh = __int_as_float(__builtin_amdgcn_readlane(__float_as_int(ur[i][h]), tt));
        dr += bbr[h] * uh; di += bbi[h] * uh;
      }
      const float nr = abr * hr - abi * hi + dr;
      const float ni = abr * hi + abi * hr + di;
      hr = nr; hi = ni;
    }
  }
  E[((size_t)(b * 32 + g) * 128 + c) * 64 + lane] = (f32x2){hr, hi};
  __syncthreads();
}
DI void s5b_item(const Params& p, int l, int item, int tid) {
  const int gid = item * 256 + tid;
  const int bg = gid >> 6, lp = gid & 63, g = bg & 31;
  const f32x4 ab4 = *(const f32x4*)((const float*)(p.ws + O_S5T) + (size_t)(g * 64 + lp) * 36);
  const float abr = ab4[0], abi = ab4[1];
  float pr = abr, pi = abi;
#pragma unroll
  for (int i = 0; i < 7; ++i) { const float nr = pr * pr - pi * pi, ni = 2.f * pr * pi; pr = nr; pi = ni; }
  f32x2* E = (f32x2*)(p.ws + O_S5E) + (size_t)bg * 128 * 64 + lp;
  float hr = 0.f, hi = 0.f;
  for (int c = 0; c < 128; c += 8) {
    f32x2 e[8];
#pragma unroll
    for (int u = 0; u < 8; ++u) e[u] = E[(size_t)(c + u) * 64];
#pragma unroll
    for (int u = 0; u < 8; ++u) {
      E[(size_t)(c + u) * 64] = (f32x2){hr, hi};
      const float nr = pr * hr - pi * hi + e[u][0];
      const float ni = pr * hi + pi * hr + e[u][1];
      hr = nr; hi = ni;
    }
  }
}
DI float gelu_tanh(float y) {
  const float u = 1.5957691216057308f * (y + 0.044715f * y * y * y);
  return y * __builtin_amdgcn_rcpf(1.f + __expf(-u));
}
DI void s5c_item(const Params& p, int l, int item, unsigned char* smem, int tid) {
  bf16_t* QK = (bf16_t*)(p.ws + O_QK);
  const f32x2* E = (const f32x2*)(p.ws + O_S5E);
  const int lane = tid & 63, wave = tid >> 6, fr = lane & 15, fq = lane >> 4;
  const int wi = item * 4 + wave;
  const int g = wi & 31, c = (wi >> 5) & 127, b = wi >> 12;
  float* us = (float*)smem + wave * 2048;
  bf16_t* Hs = (bf16_t*)(smem + 32768) + wave * 16 * LDH;
  float abr, abi;
  float bbr[16], bbi[16];
  s5_load(p, g, lane, abr, abi, bbr, bbi);
  bf16x8 cop[4];
#pragma unroll
  for (int kk = 0; kk < 4; ++kk) {
    const int k = kk * 32 + fq * 8;
    const float* src = (k < 64 ? p.s5_c_re : p.s5_c_im) + ((size_t)(l * 32 + g) * 16 + fr) * 64 + (k & 63);
    const float sg = k < 64 ? 1.f : -1.f;
    const f32x4 a = *(const f32x4*)src * sg, bq = *(const f32x4*)(src + 4) * sg;
    cop[kk] = pack8(a, bq);
  }
  const f32x4 dsk = *(const f32x4*)(p.s5_d + l * 512 + g * 16 + fq * 4);
  const size_t row0 = (size_t)b * S_ + c * 128;
#pragma unroll
  for (int i = 0; i < 2; ++i) {
    const int t = lane + 64 * i;
    const bf16_t* up = QK + (row0 + t) * 4096 + 3 * 512 + g * 16;
    const u32x4 w0 = *(const u32x4*)up, w1 = *(const u32x4*)(up + 8);
    float* d = us + t * 16;
    *(f32x4*)(d + 0) = (f32x4){bflo(w0.x), bfhi(w0.x), bflo(w0.y), bfhi(w0.y)};
    *(f32x4*)(d + 4) = (f32x4){bflo(w0.z), bfhi(w0.z), bflo(w0.w), bfhi(w0.w)};
    *(f32x4*)(d + 8) = (f32x4){bflo(w1.x), bfhi(w1.x), bflo(w1.y), bfhi(w1.y)};
    *(f32x4*)(d + 12) = (f32x4){bflo(w1.z), bfhi(w1.z), bflo(w1.w), bfhi(w1.w)};
  }
  const f32x2 e0 = E[((size_t)(b * 32 + g) * 128 + c) * 64 + lane];
  float hr = e0[0], hi = e0[1];
  __syncthreads();
  float ur[2][16];
#pragma unroll
  for (int i = 0; i < 2; ++i)
#pragma unroll
    for (int h = 0; h < 16; ++h) ur[i][h] = us[(lane + 64 * i) * 16 + h];
#pragma unroll
  for (int ih = 0; ih < 2; ++ih)
  for (int tb4 = 0; tb4 < 4; ++tb4) {
    const int tb = ih * 4 + tb4;
    for (int tt = 0; tt < 16; ++tt) {
      const int ln = tb4 * 16 + tt;
      float dr = 0.f, di = 0.f;
#pragma unroll
      for (int h = 0; h < 16; ++h) {
        const float uh = __int_as_float(__builtin_amdgcn_readlane(__float_as_int(ur[ih][h]), ln));
        dr += bbr[h] * uh; di += bbi[h] * uh;
      }
      const float nr = abr * hr - abi * hi + dr;
      const float ni = abr * hi + abi * hr + di;
      hr = nr; hi = ni;
      Hs[tt * LDH + lane] = f2bf(hr);
      Hs[tt * LDH + 64 + lane] = f2bf(hi);
    }
    __syncthreads();
    f32x4 y = zero4();
#pragma unroll
    for (int kk = 0; kk < 4; ++kk) {
      const bf16x8 hb = *(const bf16x8*)(Hs + fr * LDH + kk * 32 + fq * 8);
      y = MFMA16(cop[kk], hb, y);
    }
    const int t = tb * 16 + fr;
    const f32x4 u4 = *(const f32x4*)(us + t * 16 + fq * 4);
    f32x4 z;
#pragma unroll
    for (int r = 0; r < 4; ++r) z[r] = gelu_tanh(y[r] + dsk[r] * u4[r]);
    store_bf4(QK + (row0 + t) * 4096 + 3 * 512 + g * 16 + fq * 4, z);
    __syncthreads();
  }
}

DI void kxnorm_item(const Params& p, int l, int item, int tid) {
  const int lane = tid & 63, wave = tid >> 6;
  const int wi = item * 4 + wave;
  const int row = wi >> 2, hd = wi & 3;
  const float* src = (const float*)(p.ws + O_KXR) + (size_t)row * 1024 + hd * 256 + lane * 4;
  const f32x4 v = *(const f32x4*)src;
  float ss = v[0] * v[0] + v[1] * v[1] + v[2] * v[2] + v[3] * v[3];
  ss = wave_sum(ss);
  const float rs = rsqrtf(ss * (1.f / 256.f) + EPS);
  const f32x4 g4 = *(const f32x4*)(p.x_knorm + l * 256 + lane * 4);
  store_bf4((bf16_t*)(p.ws + O_KXN) + (size_t)row * 1024 + hd * 256 + lane * 4, v * rs * g4);
}
constexpr int LDX = 264;
DI void xattn_item(const Params& p, int l, int item, unsigned char* smem, int tid) {
  const bf16_t* QX = (const bf16_t*)(p.ws + O_QK);
  bf16_t* OX = (bf16_t*)(p.ws + O_QK) + (size_t)T_ * 1024;
  const bf16_t* KXN = (const bf16_t*)(p.ws + O_KXN);
  const bf16_t* VXT = (const bf16_t*)(p.ws + O_VXT);
  const int lane = tid & 63, wave = tid >> 6, fr = lane & 15, fq = lane >> 4;
  const int hd = item & 3, rt = item >> 2;
  const int b = rt >> 7;
  const size_t row = (size_t)rt * 128 + wave * 16 + fr;
  bf16_t* sT = (bf16_t*)smem;
  bf16x8 qf[8];
  {
    float ss = 0.f;
    f32x4 qa[8][2];
    const bf16_t* qp = QX + row * 1024 + hd * 256 + fq * 8;
#pragma unroll
    for (int kk = 0; kk < 8; ++kk) {
      const u32x4 w = *(const u32x4*)(qp + kk * 32);
      qa[kk][0] = (f32x4){bflo(w.x), bfhi(w.x), bflo(w.y), bfhi(w.y)};
      qa[kk][1] = (f32x4){bflo(w.z), bfhi(w.z), bflo(w.w), bfhi(w.w)};
#pragma unroll
      for (int e = 0; e < 4; ++e) ss += qa[kk][0][e] * qa[kk][0][e] + qa[kk][1][e] * qa[kk][1][e];
    }
    ss += __shfl_xor(ss, 16, 64); ss += __shfl_xor(ss, 32, 64);
    const float rs = rsqrtf(ss * (1.f / 256.f) + EPS) * (0.0625f * LOG2E);
    const float* gq = p.x_qnorm + l * 256 + fq * 8;
#pragma unroll
    for (int kk = 0; kk < 8; ++kk) {
      const f32x4 g0 = *(const f32x4*)(gq + kk * 32), g1 = *(const f32x4*)(gq + kk * 32 + 4);
      qf[kk] = pack8(qa[kk][0] * rs * g0, qa[kk][1] * rs * g1);
    }
  }
  f32x4 s[16];
#pragma unroll
  for (int i = 0; i < 16; ++i) s[i] = zero4();
#pragma unroll
  for (int jt = 0; jt < 4; ++jt) {
#pragma unroll
    for (int i = 0; i < 4; ++i) {
      const int cidx = tid + 512 * i, key = cidx >> 5, dc = (cidx & 31) * 8;
      *(u32x4*)(sT + key * LDX + dc) = *(const u32x4*)(KXN + ((size_t)b * 256 + jt * 64 + key) * 1024 + hd * 256 + dc);
    }
    __syncthreads();
#pragma unroll
    for (int kk = 0; kk < 8; ++kk)
#pragma unroll
      for (int mf = 0; mf < 4; ++mf) {
        const bf16x8 a = *(const bf16x8*)(sT + (mf * 16 + fr) * LDX + kk * 32 + fq * 8);
        s[jt * 4 + mf] = MFMA16(a, qf[kk], s[jt * 4 + mf]);
      }
    __syncthreads();
  }
  float mx = -1e30f;
#pragma unroll
  for (int i = 0; i < 16; ++i)
#pragma unroll
    for (int r = 0; r < 4; ++r) mx = fmaxf(mx, s[i][r]);
  mx = fmaxf(mx, __shfl_xor(mx, 16, 64)); mx = fmaxf(mx, __shfl_xor(mx, 32, 64));
  float ls = 0.f;
#pragma unroll
  for (int i = 0; i < 16; ++i)
#pragma unroll
    for (int r = 0; r < 4; ++r) { const float pv = ex2(s[i][r] - mx); s[i][r] = pv; ls += pv; }
  ls += __shfl_xor(ls, 16, 64); ls += __shfl_xor(ls, 32, 64);
  const float inv = 1.f / ls;
  bf16x8 pp[8];
#pragma unroll
  for (int i = 0; i < 8; ++i) pp[i] = pack8(s[2 * i], s[2 * i + 1]);
  f32x4 o[16];
#pragma unroll
  for (int i = 0; i < 16; ++i) o[i] = zero4();
#pragma unroll
  for (int jt = 0; jt < 4; ++jt) {
#pragma unroll
    for (int i = 0; i < 4; ++i) {
      const int cidx = tid + 512 * i, d = cidx >> 3, mc = (cidx & 7) * 8;
      *(u32x4*)(sT + d * LDK + mc) = *(const u32x4*)(VXT + ((size_t)b * 1024 + hd * 256 + d) * 256 + jt * 64 + mc);
    }
    __syncthreads();
#pragma unroll
    for (int ss = 0; ss < 2; ++ss) {
      const bf16x8 pb = pp[jt * 2 + ss];
#pragma unroll
      for (int df = 0; df < 16; ++df) {
        const bf16_t* vp = sT + (df * 16 + fr) * LDK + ss * 32 + fq * 4;
        const bf16x8 a = cat4(*(const bf16x4*)vp, *(const bf16x4*)(vp + 16));
        o[df] = MFMA16(a, pb, o[df]);
      }
    }
    __syncthreads();
  }
  bf16_t* op = OX + row * 1024 + hd * 256 + fq * 4;
#pragma unroll
  for (int df = 0; df < 16; ++df) store_bf4(op + df * 16, o[df] * inv);
}

__global__ void __launch_bounds__(512, 2) mega(Params p, int ph_lo, int ph_hi, int coop) {
  __shared__ __attribute__((aligned(16))) unsigned char smem_all[147456];
#ifdef DIAG_ZERO
  if (ph_lo == 0) {
    u32x4* w4 = (u32x4*)p.ws;
    const u32x4 z4 = {0u, 0u, 0u, 0u};
    for (size_t i = (size_t)blockIdx.x * 256 + threadIdx.x; i < O_END / 16; i += (size_t)gridDim.x * 256) w4[i] = z4;
    u32x4* o4 = (u32x4*)p.out;
    for (size_t i = (size_t)blockIdx.x * 256 + threadIdx.x; i < (size_t)T_ * 1024 / 4; i += (size_t)gridDim.x * 256) o4[i] = z4;
    for (int i = threadIdx.x; i < 73728 / 16; i += 256) ((u32x4*)smem)[i] = z4;
    __syncthreads();
    if (coop) cg::this_grid().sync();
  }
#endif
  if (coop) {
    if (blockIdx.x == 0 && threadIdx.x == 0) __hip_atomic_store((unsigned*)(p.ws + O_BAR), 0u, __ATOMIC_RELAXED, __HIP_MEMORY_SCOPE_AGENT);
    cg::this_grid().sync();
  }
  for (int ph = ph_lo; ph < ph_hi; ++ph) {
#ifdef REP_MASK
    const int nrep = ((REP_MASK >> (ph % NPH)) & 1) ? 2 : 1;
#else
    const int nrep = 1;
#endif
    for (int rep = 0; rep < nrep; ++rep) {
    int tid = threadIdx.x, G = gridDim.x * 2, bid = blockIdx.x * 2;
    asm volatile("" : "+v"(tid));
    asm volatile("" : "+s"(G));
    const int sub = __builtin_amdgcn_readfirstlane(tid >> 8);
    tid &= 255;
    bid += sub;
    unsigned char* smem = smem_all + sub * 73728;
    int t8 = threadIdx.x, WG = blockIdx.x, NWG = gridDim.x;
    asm volatile("" : "+v"(t8));
    asm volatile("" : "+s"(WG));
    asm volatile("" : "+s"(NWG));
    const int wr8 = t8 >> 7, wc8 = (t8 >> 6) & 1;
    const int wr2 = t8 >> 8, wc4 = (t8 >> 6) & 3;
    const int lane = tid & 63, wave = tid >> 6, wr = wave >> 1, wc = wave & 1, fr = lane & 15, fq = lane >> 4;
    unsigned char* ws = p.ws;
    asm volatile("" : "+s"(ws));
    bf16_t* HB = (bf16_t*)(ws + O_HB);
    bf16_t* QK = (bf16_t*)(ws + O_QK);
    const int l = ph / NPH;
#ifdef ONLY_SP
    const int sp = ONLY_SP;
#else
    const int sp = ph % NPH;
#endif
    const float* xin = (l == 0) ? p.x : p.out;
    if (sp == 0) {
      float* wfft = (float*)smem;
      bf16_t* ctile = (bf16_t*)(smem + 32768);
      {
        const float* wsrc = p.w_in + (size_t)l * D_ * INC + 1536;
        for (int i = tid; i < 2048; i += 256) {
          const int k = i >> 1, j4 = (i & 1) * 4;
          const f32x4 v = *(const f32x4*)(wsrc + (size_t)k * INC + j4);
          wfft[(j4 + 0) * 1024 + k] = v[0]; wfft[(j4 + 1) * 1024 + k] = v[1];
          wfft[(j4 + 2) * 1024 + k] = v[2]; wfft[(j4 + 3) * 1024 + k] = v[3];
        }
        __syncthreads();
      }
      const int total = 1024 + 16 + N_CONV + 8;
      for (int it = bid; it < total; it += G) {
        if (it < 1024) norm_item(xin, p.norm_mix + l * 1024, HB, it * 32, wfft, (float*)(ws + O_LOGF), p.fox_fbias + l * 8, tid);
        else if (it < 1040) norm_item(p.mem, p.norm_mem + l * 1024, (bf16_t*)(ws + O_MEMN), (it - 1024) * 32, nullptr, nullptr, nullptr, tid);
        else if (it < 1040 + N_CONV) conv_item(p, l, it - 1040, ctile, tid);
        else s5tab_item(p, l, it - 1040 - N_CONV, tid);
      }
    } else if (sp == 1) {
      for (int it = bid; it < 16 + 64; it += G) {
        if (it < 16) { cumsum_item(p, it, smem, tid); continue; }
        f32x4 acc[4][4];
        zero_acc<4>(acc);
        const int t = it - 16, nt = t & 15, mt = t >> 4;
        const int m0 = mt * 128, n0 = (nt & 7) * 128;
        const bf16_t* W = (const bf16_t*)(ws + (nt < 8 ? O_WXK : O_WXV));
        gemm_core<4>((const bf16_t*)(ws + O_MEMN) + (size_t)m0 * 1024, 1024, W + (size_t)n0 * 1024, 1024, 1024, acc, smem, tid);
        if (nt < 8) {
          float* KXR = (float*)(ws + O_KXR);
#pragma unroll
          for (int mi = 0; mi < 4; ++mi) {
            const size_t row = m0 + wr * 64 + mi * 16 + fr;
#pragma unroll
            for (int ni = 0; ni < 4; ++ni) *(f32x4*)(KXR + row * 1024 + n0 + wc * 64 + ni * 16 + fq * 4) = acc[mi][ni];
          }
        } else {
          bf16_t* VXT = (bf16_t*)(ws + O_VXT);
#pragma unroll
          for (int mi = 0; mi < 4; ++mi) {
            const int row = m0 + wr * 64 + mi * 16 + fr, bb = row >> 8, mm = row & 255;
#pragma unroll
            for (int ni = 0; ni < 4; ++ni)
#pragma unroll
              for (int r = 0; r < 4; ++r) VXT[((size_t)bb * 1024 + n0 + wc * 64 + ni * 16 + fq * 4 + r) * 256 + mm] = f2bf(acc[mi][ni][r]);
          }
        }
      }
      for (int it = WG; it < 2048; it += NWG) {
        int nt, mt; xcd_tile(it, WG, NWG, 16, mt, nt);
        const int m0 = mt * 256, n0 = nt * 256;
        f32x4 acc[2][2][4][2];
        zero_acc8p(acc);
        gemm8p(HB + (size_t)m0 * 1024, 1024, (const bf16_t*)(ws + O_WP) + (size_t)n0 * 1024, 1024, 1024, acc, smem_all, t8);
        const int slot = n0 >> 9;
        if (slot < 2) {
          const float* gn = (slot == 0 ? p.fox_qnorm : p.fox_knorm) + l * 64 + (wc4 & 1) * 32 + fq * 4;
          const float scl = slot == 0 ? 0.125f * LOG2E : 1.f;
          float* xs = (float*)smem_all;
          const int wid8 = t8 >> 6;
          float part[2][2][4];
#pragma unroll
          for (int ai = 0; ai < 2; ++ai)
#pragma unroll
            for (int bj = 0; bj < 2; ++bj)
#pragma unroll
              for (int m = 0; m < 4; ++m) {
                float ss = 0.f;
#pragma unroll
                for (int n = 0; n < 2; ++n)
#pragma unroll
                  for (int r = 0; r < 4; ++r) ss += acc[ai][bj][m][n][r] * acc[ai][bj][m][n][r];
                ss += __shfl_xor(ss, 16, 64); ss += __shfl_xor(ss, 32, 64);
                part[ai][bj][m] = ss;
                if (fq == 0) xs[(wid8 * 16 + (ai * 2 + bj) * 4 + m) * 16 + fr] = ss;
              }
          __syncthreads();
          const f32x4 g0 = *(const f32x4*)gn, g1 = *(const f32x4*)(gn + 16);
#pragma unroll
          for (int ai = 0; ai < 2; ++ai)
#pragma unroll
            for (int m = 0; m < 4; ++m) {
              const size_t row = m0 + ai * 128 + wr2 * 64 + m * 16 + fr;
#pragma unroll
              for (int bj = 0; bj < 2; ++bj) {
                const float tot = part[ai][bj][m] + xs[((wid8 ^ 1) * 16 + (ai * 2 + bj) * 4 + m) * 16 + fr];
                const float rs = rsqrtf(tot * (1.f / 64.f) + EPS) * scl;
                bf16_t* dst = QK + row * 4096 + n0 + bj * 128 + wc4 * 32 + fq * 4;
                store_bf4(dst, acc[ai][bj][m][0] * rs * g0);
                store_bf4(dst + 16, acc[ai][bj][m][1] * rs * g1);
              }
            }
          __syncthreads();
        } else {
#pragma unroll
          for (int ai = 0; ai < 2; ++ai)
#pragma unroll
            for (int m = 0; m < 4; ++m) {
              const size_t row = m0 + ai * 128 + wr2 * 64 + m * 16 + fr;
#pragma unroll
              for (int bj = 0; bj < 2; ++bj)
#pragma unroll
                for (int n = 0; n < 2; ++n) store_bf4(QK + row * 4096 + n0 + bj * 128 + wc4 * 32 + n * 16 + fq * 4, acc[ai][bj][m][n]);
            }
        }
      }
    } else if (sp == 2) {
      const int total = 2048 + 2048 + 512;
      for (int it = bid; it < total; it += G) {
        if (it < 2048) hg1_item(p, l, it, smem, tid);
        else if (it < 4096) s5a_item(p, l, it - 2048, smem, tid);
        else kxnorm_item(p, l, it - 4096, tid);
      }
    } else if (sp == 3) {
      const int total = 256 + 16;
      for (int it = bid; it < total; it += G) {
        if (it < 256) hg2_item(p, it, tid);
        else s5b_item(p, l, it - 256, tid);
      }
    } else if (sp == 4) {
      for (int it = WG; it < 1024; it += NWG) {
        int idx = it;
        const int j = it / NWG;
        if ((j & 1) && (j + 1) * NWG <= 1024) idx = j * NWG + (NWG - 1 - (it - j * NWG));
        fox_item(p, l, idx, smem_all, t8);
      }
      for (int it = bid; it < 4096; it += G) {
        if (it < 2048) hg3_item(p, l, it, smem, tid);
        else s5c_item(p, l, it - 2048, smem, tid);
      }
    } else if (sp == 5) {
      const float* bg = p.s5_b_glu + l * 512;
      for (int it = WG; it < 256; it += NWG) {
        int nt, mt; xcd_tile(it, WG, NWG, 2, mt, nt);
        const int m0 = mt * 256, n0 = nt * 256;
        f32x4 acc[2][2][4][2];
        zero_acc8p(acc);
        gemm8p(QK + (size_t)m0 * 4096 + 3 * 512, 4096, (const bf16_t*)(ws + O_WGLU) + (size_t)n0 * 512, 512, 512, acc, smem_all, t8);
#pragma unroll
        for (int ai = 0; ai < 2; ++ai)
#pragma unroll
          for (int m = 0; m < 4; ++m) {
            const size_t row = m0 + ai * 128 + wr2 * 64 + m * 16 + fr;
#pragma unroll
            for (int bj = 0; bj < 2; ++bj)
#pragma unroll
              for (int n = 0; n < 2; ++n) {
                const int col = n0 + bj * 128 + wc4 * 32 + n * 16 + fq * 4;
                const f32x4 b4 = *(const f32x4*)(bg + col);
                const u32x2 zw = *(const u32x2*)(QK + row * 4096 + 3 * 512 + col);
                const f32x4 z = {bflo(zw.x), bfhi(zw.x), bflo(zw.y), bfhi(zw.y)};
                f32x4 y;
#pragma unroll
                for (int r = 0; r < 4; ++r) y[r] = z[r] * sigmoidf_(acc[ai][bj][m][n][r] + b4[r]);
                store_bf4(QK + row * 4096 + 5 * 512 + col, y);
              }
          }
      }
    } else if (sp == 6) {
      for (int it = WG; it < 512; it += NWG) {
        int nt, mt; xcd_tile(it, WG, NWG, 4, mt, nt);
        const int m0 = mt * 256, n0 = nt * 256;
#pragma unroll 1
        for (int br = 0; br < 3; ++br) {
          f32x4 acc[2][2][4][2];
          zero_acc8p(acc);
          gemm8p(HB + (size_t)m0 * 1024, 1024, (const bf16_t*)(ws + O_WG) + (size_t)(br * 1024 + n0) * 1024, 1024, 1024, acc, smem_all, t8);
          { int tq = threadIdx.x; asm volatile("" : "+v"(tq));
          u32x4* gs = (u32x4*)(ws + O_GS) + ((size_t)WG * 512 + tq) * 16;
#pragma unroll
          for (int ai = 0; ai < 2; ++ai)
#pragma unroll
            for (int bj = 0; bj < 2; ++bj)
#pragma unroll
              for (int m = 0; m < 4; ++m) {
                u32x4 g;
                g.x = pk2(sigmoidf_(acc[ai][bj][m][0][0]), sigmoidf_(acc[ai][bj][m][0][1]));
                g.y = pk2(sigmoidf_(acc[ai][bj][m][0][2]), sigmoidf_(acc[ai][bj][m][0][3]));
                g.z = pk2(sigmoidf_(acc[ai][bj][m][1][0]), sigmoidf_(acc[ai][bj][m][1][1]));
                g.w = pk2(sigmoidf_(acc[ai][bj][m][1][2]), sigmoidf_(acc[ai][bj][m][1][3]));
                gs[(ai * 2 + bj) * 4 + m] = g;
              }
          }
          zero_acc8p(acc);
          const bf16_t* Ab = br == 0 ? (const bf16_t*)(ws + O_YF) + (size_t)m0 * 512 : QK + (size_t)m0 * 4096 + (br == 1 ? 5 : 4) * 512;
          gemm8p(Ab, br == 0 ? 512 : 4096, (const bf16_t*)(ws + O_WBR) + (size_t)br * 1024 * 512 + (size_t)n0 * 512, 512, 512, acc, smem_all, t8);
          int tq2 = threadIdx.x; asm volatile("" : "+v"(tq2));
          const u32x4* gs = (const u32x4*)(ws + O_GS) + ((size_t)WG * 512 + tq2) * 16;
          const int fr_e = tq2 & 15, fq_e = (tq2 >> 4) & 3, wr_e = tq2 >> 8, wc_e = (tq2 >> 6) & 3;
#pragma unroll
          for (int ai = 0; ai < 2; ++ai)
#pragma unroll
            for (int m = 0; m < 4; ++m) {
              const size_t row = m0 + ai * 128 + wr_e * 64 + m * 16 + fr_e;
#pragma unroll
              for (int bj = 0; bj < 2; ++bj) {
                const u32x4 g = gs[(ai * 2 + bj) * 4 + m];
                bf16_t* dst = QK + row * 4096 + 512 + n0 + bj * 128 + wc_e * 32 + fq_e * 4;
                f32x4 v0 = acc[ai][bj][m][0] * (f32x4){bflo(g.x), bfhi(g.x), bflo(g.y), bfhi(g.y)};
                f32x4 v1 = acc[ai][bj][m][1] * (f32x4){bflo(g.z), bfhi(g.z), bflo(g.w), bfhi(g.w)};
                if (br > 0) {
                  const u32x2 o0 = *(const u32x2*)dst, o1 = *(const u32x2*)(dst + 16);
                  v0 += (f32x4){bflo(o0.x), bfhi(o0.x), bflo(o0.y), bfhi(o0.y)};
                  v1 += (f32x4){bflo(o1.x), bfhi(o1.x), bflo(o1.y), bfhi(o1.y)};
                }
                store_bf4(dst, v0);
                store_bf4(dst + 16, v1);
              }
            }
        }
      }
    } else if (sp == 7 || sp == 11 || sp == 14) {
      const bf16_t* A; int lda, K; const bf16_t* W;
      const float* rin;
      if (sp == 7) { A = QK + 512; lda = 4096; K = 1024; W = (const bf16_t*)(ws + O_WOUT); rin = xin; }
      else if (sp == 11) { A = QK + (size_t)T_ * 1024; lda = 1024; K = 1024; W = (const bf16_t*)(ws + O_WXO); rin = p.out; }
      else { A = QK; lda = DFF; K = DFF; W = (const bf16_t*)(ws + O_WD); rin = p.out; }
      for (int it = WG; it < 512; it += NWG) {
        int nt, mt; xcd_tile(it, WG, NWG, 4, mt, nt);
        const int m0 = mt * 256, n0 = nt * 256;
        f32x4 acc[2][2][4][2];
        zero_acc8p(acc);
        gemm8p(A + (size_t)m0 * lda, lda, W + (size_t)n0 * K, K, K, acc, smem_all, t8);
#pragma unroll
        for (int ai = 0; ai < 2; ++ai)
#pragma unroll
          for (int m = 0; m < 4; ++m) {
            const size_t row = m0 + ai * 128 + wr2 * 64 + m * 16 + fr;
#pragma unroll
            for (int bj = 0; bj < 2; ++bj)
#pragma unroll
              for (int n = 0; n < 2; ++n) {
                const size_t o = row * 1024 + n0 + bj * 128 + wc4 * 32 + n * 16 + fq * 4;
                *(f32x4*)(p.out + o) = *(const f32x4*)(rin + o) + acc[ai][bj][m][n];
              }
          }
      }
    } else if (sp == 8 || sp == 12) {
      const float* gn = (sp == 8 ? p.norm_x : p.norm_ffn) + l * 1024;
      for (int it = bid; it < 1024; it += G) norm_item(p.out, gn, HB, it * 32, nullptr, nullptr, nullptr, tid);
    } else if (sp == 9) {
      for (int it = WG; it < 512; it += NWG) {
        int nt, mt; xcd_tile(it, WG, NWG, 4, mt, nt);
        const int m0 = mt * 256, n0 = nt * 256;
        f32x4 acc[2][2][4][2];
        zero_acc8p(acc);
        gemm8p(HB + (size_t)m0 * 1024, 1024, (const bf16_t*)(ws + O_WXQ) + (size_t)n0 * 1024, 1024, 1024, acc, smem_all, t8);
#pragma unroll
        for (int ai = 0; ai < 2; ++ai)
#pragma unroll
          for (int m = 0; m < 4; ++m) {
            const size_t row = m0 + ai * 128 + wr2 * 64 + m * 16 + fr;
#pragma unroll
            for (int bj = 0; bj < 2; ++bj)
#pragma unroll
              for (int n = 0; n < 2; ++n) store_bf4(QK + row * 1024 + n0 + bj * 128 + wc4 * 32 + n * 16 + fq * 4, acc[ai][bj][m][n]);
          }
      }
    } else if (sp == 10) {
      for (int it = WG; it < 1024; it += NWG) xattn_item(p, l, it, smem_all, t8);
    } else if (sp == 13) {
      for (int it = WG; it < 128 * 22; it += NWG) {
        int nt, mt; xcd_tile(it, WG, NWG, 22, mt, nt);
        const int m0 = mt * 256, n0 = nt * 256;
        f32x4 acc[2][2][4][2];
        zero_acc8p(acc);
        gemm8p(HB + (size_t)m0 * 1024, 1024, (const bf16_t*)(ws + O_WGU) + (size_t)n0 * 1024, 1024, 1024, acc, smem_all, t8);
#pragma unroll
        for (int ai = 0; ai < 2; ++ai)
#pragma unroll
          for (int m = 0; m < 4; ++m) {
            const size_t row = m0 + ai * 128 + wr2 * 64 + m * 16 + fr;
#pragma unroll
            for (int bj = 0; bj < 2; ++bj) {
              f32x4 y;
#pragma unroll
              for (int r = 0; r < 4; ++r) { const float a = acc[ai][bj][m][0][r]; y[r] = a * sigmoidf_(a) * acc[ai][bj][m][1][r]; }
              store_bf4(QK + row * DFF + nt * 128 + bj * 64 + wc4 * 16 + fq * 4, y);
            }
          }
      }
    }
    }
    if (coop && ph + 1 < ph_hi) {
      unsigned* bar = (unsigned*)(p.ws + O_BAR);
      __builtin_amdgcn_fence(__ATOMIC_RELEASE, "workgroup");
      asm volatile("s_waitcnt vmcnt(0)" ::: "memory");
      __syncthreads();
      if (threadIdx.x == 0) {
        const unsigned target = (unsigned)(ph - ph_lo + 1) * gridDim.x;
        __builtin_amdgcn_fence(__ATOMIC_RELEASE, "agent");
        __hip_atomic_fetch_add(bar, 1u, __ATOMIC_RELAXED, __HIP_MEMORY_SCOPE_AGENT);
        while (__hip_atomic_load(bar, __ATOMIC_RELAXED, __HIP_MEMORY_SCOPE_AGENT) < target) __builtin_amdgcn_s_sleep(1);
        __builtin_amdgcn_fence(__ATOMIC_ACQUIRE, "agent");
      }
      __syncthreads();
    }
#ifdef EXTRA_SYNC
    if (coop) for (int e = 0; e < EXTRA_SYNC; ++e) cg::this_grid().sync();
#endif
  }
}

extern "C" void kernel_launch(void* const* d_in, const int* in_sizes, int n_in, void* d_out, int out_size, void* d_ws,
                              size_t ws_size, hipStream_t stream) {
  Params p{};
  const float** pp = (const float**)&p;
  for (int i = 0; i < 32; ++i) pp[i] = (const float*)d_in[i];
  p.out = (float*)d_out;
  p.ws = (unsigned char*)d_ws;
  if (ws_size < O_END) return;
  static int grid = 0;
  if (!grid) {
    int dev = 0, cus = 0, per_cu = 0;
    hipGetDevice(&dev);
    hipDeviceGetAttribute(&cus, hipDeviceAttributeMultiprocessorCount, dev);
    hipOccupancyMaxActiveBlocksPerMultiprocessor(&per_cu, mega, 512, 0);
    if (per_cu < 1) per_cu = 1;
    if (per_cu > 1) per_cu = 1;
    grid = cus * per_cu;
  }
#if MK_MULTI
  for (int ph = 0; ph < NL * NPH; ++ph) hipLaunchKernelGGL(mega, dim3(grid), dim3(512), 0, stream, p, ph, ph + 1, 0);
#else
  int lo = 0, hi = NL * NPH, coop = 1;
  void* args[] = {&p, &lo, &hi, &coop};
  hipError_t e = hipLaunchCooperativeKernel((void*)mega, dim3(grid), dim3(512), args, 0, stream);
  if (e != hipSuccess) fprintf(stderr, "cooperative launch failed: %s (grid %d)\n", hipGetErrorString(e), grid);
#endif
}
```

```cpp
#include <hip/hip_runtime.h>
#include <hip/hip_cooperative_groups.h>
#include <cstdio>
#include <cstdint>
namespace cg = cooperative_groups;

#ifndef MK_MULTI
#define MK_MULTI 0
#endif

typedef unsigned short bf16_t;
typedef short bf16x8 __attribute__((ext_vector_type(8)));
typedef short bf16x4 __attribute__((ext_vector_type(4)));
typedef float f32x4 __attribute__((ext_vector_type(4)));
typedef float f32x2 __attribute__((ext_vector_type(2)));
typedef __bf16 hbf2 __attribute__((ext_vector_type(2)));
typedef unsigned u32x4 __attribute__((ext_vector_type(4)));
typedef unsigned u32x2 __attribute__((ext_vector_type(2)));

#define DI __device__ __forceinline__
#define MFMA16(a, b, c) __builtin_amdgcn_mfma_f32_16x16x32_bf16((a), (b), (c), 0, 0, 0)

constexpr int T_ = 32768, S_ = 16384, D_ = 1024, NL = 4;
constexpr int INC = 7176, DFF = 2816;
constexpr float LOG2E = 1.4426950408889634f;
constexpr float EPS = 1e-6f;
constexpr int NPH = 15;

constexpr size_t O_WP = 0;
constexpr size_t O_WG = O_WP + 4096ull * 1024 * 2;
constexpr size_t O_WBR = O_WG + 3072ull * 1024 * 2;
constexpr size_t O_WOUT = O_WBR + 3ull * 1024 * 512 * 2;
constexpr size_t O_WXQ = O_WOUT + 1024ull * 1024 * 2;
constexpr size_t O_WXK = O_WXQ + 1024ull * 1024 * 2;
constexpr size_t O_WXV = O_WXK + 1024ull * 1024 * 2;
constexpr size_t O_WXO = O_WXV + 1024ull * 1024 * 2;
constexpr size_t O_WGU = O_WXO + 1024ull * 1024 * 2;
constexpr size_t O_WD = O_WGU + 5632ull * 1024 * 2;
constexpr size_t O_WGLU = O_WD + 1024ull * 2816 * 2;
constexpr size_t O_HB = O_WGLU + 512ull * 512 * 2;
constexpr size_t O_QK = O_HB + (size_t)T_ * 1024 * 2;
constexpr size_t O_SBUF = O_QK + (size_t)T_ * 4096 * 2;
constexpr size_t O_DCY = O_SBUF + 2048ull * 128 * 128 * 2;
constexpr size_t O_LOGF = O_DCY + 2048ull * 128 * 4;
constexpr size_t O_CUM = O_LOGF + (size_t)T_ * 8 * 4;
constexpr size_t O_S5E = O_CUM + (size_t)T_ * 8 * 4;
constexpr size_t O_MEMN = O_S5E + 2ull * 32 * 128 * 64 * 8;
constexpr size_t O_KXR = O_MEMN + 512ull * 1024 * 2;
constexpr size_t O_KXN = O_KXR + 512ull * 1024 * 4;
constexpr size_t O_VXT = O_KXN + 512ull * 1024 * 2;
constexpr size_t O_S5T = O_VXT + 512ull * 1024 * 2;
constexpr size_t O_YF = O_S5T + 32ull * 64 * 36 * 4;
constexpr size_t O_BAR = O_YF + (size_t)T_ * 512 * 2;
constexpr size_t O_GS = O_BAR + 256;
constexpr size_t O_END = O_GS + 256ull * 512 * 256;

struct Params {
  const float *x, *mem, *norm_mix, *w_in, *fox_fbias, *fox_qnorm, *fox_knorm, *s5_a_re, *s5_a_im, *s5_b_re, *s5_b_im,
      *s5_c_re, *s5_c_im, *s5_d, *s5_log_dt, *s5_w_glu, *s5_b_glu, *hg_lb, *hg_onorm, *w_branch, *w_out, *norm_x,
      *norm_mem, *xq, *xk, *xv, *xo, *x_qnorm, *x_knorm, *norm_ffn, *w_gate_up, *w_down;
  float* out;
  unsigned char* ws;
};

DI unsigned pk2(float a, float b) {
  f32x2 v = {a, b};
  hbf2 r = __builtin_convertvector(v, hbf2);
  return __builtin_bit_cast(unsigned, r);
}
DI bf16_t f2bf(float a) { return (bf16_t)(pk2(a, 0.f) & 0xffffu); }
DI float bf2f(bf16_t v) { return __uint_as_float((unsigned)v << 16); }
DI float bflo(unsigned u) { return __uint_as_float(u << 16); }
DI float bfhi(unsigned u) { return __uint_as_float(u & 0xffff0000u); }
DI float wave_sum(float v) {
  v += __shfl_xor(v, 32, 64); v += __shfl_xor(v, 16, 64); v += __shfl_xor(v, 8, 64);
  v += __shfl_xor(v, 4, 64); v += __shfl_xor(v, 2, 64); v += __shfl_xor(v, 1, 64);
  return v;
}
DI float sigmoidf_(float x) { return __builtin_amdgcn_rcpf(1.f + __expf(-x)); }
DI float ex2(float x) { return __builtin_amdgcn_exp2f(x); }
DI f32x4 zero4() { return (f32x4){0.f, 0.f, 0.f, 0.f}; }
DI void store_bf4(bf16_t* p, f32x4 v) { u32x2 w; w.x = pk2(v[0], v[1]); w.y = pk2(v[2], v[3]); *(u32x2*)p = w; }
DI bf16x8 pack8(f32x4 a, f32x4 b) {
  u32x4 w; w.x = pk2(a[0], a[1]); w.y = pk2(a[2], a[3]); w.z = pk2(b[0], b[1]); w.w = pk2(b[2], b[3]);
  return __builtin_bit_cast(bf16x8, w);
}
DI bf16x8 cat4(bf16x4 lo, bf16x4 hi) { return __builtin_shufflevector(lo, hi, 0, 1, 2, 3, 4, 5, 6, 7); }

constexpr int LDT = 72;
template <int NI>
DI void gemm_core(const bf16_t* __restrict__ A, int lda, const bf16_t* __restrict__ Bt, int ldb, int K,
                  f32x4 (&acc)[4][NI], unsigned char* smem, int tid) {
  constexpr int BN = 32 * NI;
  constexpr int NB = BN / 32;
  bf16_t* sA = (bf16_t*)smem;
  bf16_t* sB = sA + 2 * 128 * LDT;
  const int lane = tid & 63, wave = tid >> 6, wr = wave >> 1, wc = wave & 1, fr = lane & 15, fq = lane >> 4;
  const int lrow = tid >> 3, lkc = (tid & 7) * 8;
  u32x4 ra[4], rb[NB];
  const int nk = K >> 6;
  const bf16_t* ga = A + (size_t)lrow * lda + lkc;
  const bf16_t* gb = Bt + (size_t)lrow * ldb + lkc;
#pragma unroll
  for (int i = 0; i < 4; ++i) ra[i] = *(const u32x4*)(ga + (size_t)(32 * i) * lda);
#pragma unroll
  for (int i = 0; i < NB; ++i) rb[i] = *(const u32x4*)(gb + (size_t)(32 * i) * ldb);
#pragma unroll
  for (int i = 0; i < 4; ++i) *(u32x4*)(sA + (lrow + 32 * i) * LDT + lkc) = ra[i];
#pragma unroll
  for (int i = 0; i < NB; ++i) *(u32x4*)(sB + (lrow + 32 * i) * LDT + lkc) = rb[i];
  __syncthreads();
  for (int kt = 0; kt < nk; ++kt) {
    const int buf = kt & 1;
    if (kt + 1 < nk) {
#pragma unroll
      for (int i = 0; i < 4; ++i) ra[i] = *(const u32x4*)(ga + (size_t)(32 * i) * lda + (kt + 1) * 64);
#pragma unroll
      for (int i = 0; i < NB; ++i) rb[i] = *(const u32x4*)(gb + (size_t)(32 * i) * ldb + (kt + 1) * 64);
    }
    const bf16_t* pa = sA + buf * 128 * LDT + (wr * 64 + fr) * LDT + fq * 8;
    const bf16_t* pb = sB + buf * BN * LDT + (wc * 16 * NI + fr) * LDT + fq * 8;
#pragma unroll
    for (int kk = 0; kk < 2; ++kk) {
      bf16x8 af[4], bfr[NI];
#pragma unroll
      for (int i = 0; i < 4; ++i) af[i] = *(const bf16x8*)(pa + i * 16 * LDT + kk * 32);
#pragma unroll
      for (int i = 0; i < NI; ++i) bfr[i] = *(const bf16x8*)(pb + i * 16 * LDT + kk * 32);
#pragma unroll
      for (int mi = 0; mi < 4; ++mi)
#pragma unroll
        for (int ni = 0; ni < NI; ++ni) acc[mi][ni] = MFMA16(bfr[ni], af[mi], acc[mi][ni]);
    }
    if (kt + 1 < nk) {
      const int nb = buf ^ 1;
#pragma unroll
      for (int i = 0; i < 4; ++i) *(u32x4*)(sA + nb * 128 * LDT + (lrow + 32 * i) * LDT + lkc) = ra[i];
#pragma unroll
      for (int i = 0; i < NB; ++i) *(u32x4*)(sB + nb * BN * LDT + (lrow + 32 * i) * LDT + lkc) = rb[i];
    }
    __syncthreads();
  }
}
DI void gemm_core8(const bf16_t* __restrict__ A, int lda, const bf16_t* __restrict__ Bt, int ldb, int K,
                   f32x4 (&acc)[4][8], unsigned char* smem, int t8) {
  bf16_t* sA = (bf16_t*)smem;
  bf16_t* sB = sA + 2 * 256 * LDT;
  const int lane = t8 & 63, wave = t8 >> 6, wr = wave >> 1, wc = wave & 1, fr = lane & 15, fq = lane >> 4;
  const int lrow = t8 >> 3, lkc = (t8 & 7) * 8;
  u32x4 ra[4], rb[4];
  const int nk = K >> 6;
  const bf16_t* ga = A + (size_t)lrow * lda + lkc;
  const bf16_t* gb = Bt + (size_t)lrow * ldb + lkc;
#pragma unroll
  for (int i = 0; i < 4; ++i) { ra[i] = *(const u32x4*)(ga + (size_t)(64 * i) * lda); rb[i] = *(const u32x4*)(gb + (size_t)(64 * i) * ldb); }
#pragma unroll
  for (int i = 0; i < 4; ++i) { *(u32x4*)(sA + (lrow + 64 * i) * LDT + lkc) = ra[i]; *(u32x4*)(sB + (lrow + 64 * i) * LDT + lkc) = rb[i]; }
  __syncthreads();
  for (int kt = 0; kt < nk; ++kt) {
    const int buf = kt & 1;
    if (kt + 1 < nk) {
#pragma unroll
      for (int i = 0; i < 4; ++i) { ra[i] = *(const u32x4*)(ga + (size_t)(64 * i) * lda + (kt + 1) * 64); rb[i] = *(const u32x4*)(gb + (size_t)(64 * i) * ldb + (kt + 1) * 64); }
    }
    const bf16_t* pa = sA + buf * 256 * LDT + (wr * 64 + fr) * LDT + fq * 8;
    const bf16_t* pb = sB + buf * 256 * LDT + (wc * 128 + fr) * LDT + fq * 8;
#pragma unroll
    for (int kk = 0; kk < 2; ++kk) {
      bf16x8 af[4];
#pragma unroll
      for (int i = 0; i < 4; ++i) af[i] = *(const bf16x8*)(pa + i * 16 * LDT + kk * 32);
#pragma unroll
      for (int nh = 0; nh < 2; ++nh) {
        bf16x8 bfr[4];
#pragma unroll
        for (int i = 0; i < 4; ++i) bfr[i] = *(const bf16x8*)(pb + (nh * 4 + i) * 16 * LDT + kk * 32);
#pragma unroll
        for (int mi = 0; mi < 4; ++mi)
#pragma unroll
          for (int ni = 0; ni < 4; ++ni) acc[mi][nh * 4 + ni] = MFMA16(bfr[ni], af[mi], acc[mi][nh * 4 + ni]);
      }
    }
    if (kt + 1 < nk) {
      const int nb = buf ^ 1;
#pragma unroll
      for (int i = 0; i < 4; ++i) { *(u32x4*)(sA + nb * 256 * LDT + (lrow + 64 * i) * LDT + lkc) = ra[i]; *(u32x4*)(sB + nb * 256 * LDT + (lrow + 64 * i) * LDT + lkc) = rb[i]; }
    }
    __syncthreads();
  }
}
DI void gemm_core8b(const bf16_t* __restrict__ A, int lda, const bf16_t* __restrict__ Bt, int ldb, int K,
                    f32x4 (&acc)[4][4], unsigned char* smem, int t8) {
  bf16_t* sA = (bf16_t*)smem;
  bf16_t* sB = sA + 2 * 256 * LDT;
  const int lane = t8 & 63, wave = t8 >> 6, wr = wave >> 1, wc = wave & 1, fr = lane & 15, fq = lane >> 4;
  const int lrow = t8 >> 3, lkc = (t8 & 7) * 8;
  u32x4 ra[4], rb[2];
  const int nk = K >> 6;
  const bf16_t* ga = A + (size_t)lrow * lda + lkc;
  const bf16_t* gb = Bt + (size_t)lrow * ldb + lkc;
#pragma unroll
  for (int i = 0; i < 4; ++i) ra[i] = *(const u32x4*)(ga + (size_t)(64 * i) * lda);
#pragma unroll
  for (int i = 0; i < 2; ++i) rb[i] = *(const u32x4*)(gb + (size_t)(64 * i) * ldb);
#pragma unroll
  for (int i = 0; i < 4; ++i) *(u32x4*)(sA + (lrow + 64 * i) * LDT + lkc) = ra[i];
#pragma unroll
  for (int i = 0; i < 2; ++i) *(u32x4*)(sB + (lrow + 64 * i) * LDT + lkc) = rb[i];
  __syncthreads();
  for (int kt = 0; kt < nk; ++kt) {
    const int buf = kt & 1;
    if (kt + 1 < nk) {
#pragma unroll
      for (int i = 0; i < 4; ++i) ra[i] = *(const u32x4*)(ga + (size_t)(64 * i) * lda + (kt + 1) * 64);
#pragma unroll
      for (int i = 0; i < 2; ++i) rb[i] = *(const u32x4*)(gb + (size_t)(64 * i) * ldb + (kt + 1) * 64);
    }
    const bf16_t* pa = sA + buf * 256 * LDT + (wr * 64 + fr) * LDT + fq * 8;
    const bf16_t* pb = sB + buf * 128 * LDT + (wc * 64 + fr) * LDT + fq * 8;
#pragma unroll
    for (int kk = 0; kk < 2; ++kk) {
      bf16x8 af[4];
#pragma unroll
      for (int i = 0; i < 4; ++i) af[i] = *(const bf16x8*)(pa + i * 16 * LDT + kk * 32);
#pragma unroll
      for (int nh = 0; nh < 2; ++nh) {
        bf16x8 bfr[2];
#pragma unroll
        for (int i = 0; i < 2; ++i) bfr[i] = *(const bf16x8*)(pb + (nh * 2 + i) * 16 * LDT + kk * 32);
#pragma unroll
        for (int mi = 0; mi < 4; ++mi)
#pragma unroll
          for (int ni = 0; ni < 2; ++ni) acc[mi][nh * 2 + ni] = MFMA16(bfr[ni], af[mi], acc[mi][nh * 2 + ni]);
      }
    }
    if (kt + 1 < nk) {
      const int nb = buf ^ 1;
#pragma unroll
      for (int i = 0; i < 4; ++i) *(u32x4*)(sA + nb * 256 * LDT + (lrow + 64 * i) * LDT + lkc) = ra[i];
#pragma unroll
      for (int i = 0; i < 2; ++i) *(u32x4*)(sB + nb * 128 * LDT + (lrow + 64 * i) * LDT + lkc) = rb[i];
    }
    __syncthreads();
  }
}
DI int lds_byte8(int r, int c) { const int st = (r >> 4) * 2 + (c >> 5), rr = r & 15, cc = c & 31, ob = rr * 64 + cc * 2; return st * 1024 + (ob ^ (((ob >> 9) & 1) << 5)); }
DI void stage_rc8(int b, int& R, int& C) { const int st = b / 1024, sb = b % 1024, swz = sb ^ (((sb >> 9) & 1) << 5); R = (st >> 1) * 16 + swz / 64; C = (st & 1) * 32 + (swz % 64) / 2; }
DI void gemm8p(const bf16_t* __restrict__ A, int lda, const bf16_t* __restrict__ Bt, int ldb, int K,
               f32x4 (&acc)[2][2][4][2], unsigned char* smem, int t8) {
  const int wid = t8 >> 6, lane = t8 & 63, wr = wid >> 2, wc = wid & 3, fr = lane & 15, fq = lane >> 4;
  const int frag = (fr * 64 + fq * 16) ^ ((fr >> 3) << 5);
  const char* pA = (const char*)smem + wr * 8192 + frag;
  const char* pB = (const char*)smem + 4 * 16384 + wc * 4096 + frag;
  const int swz = ((lane * 16) ^ ((lane >> 5) << 5));
  const int R0 = (wid >> 1) * 16 + (swz >> 6), C0 = (wid & 1) * 32 + ((swz & 63) >> 1);
  unsigned offA = (unsigned)(R0 * lda + C0), offB = (unsigned)(R0 * ldb + C0);
  char* pS = (char*)smem + t8 * 16;
#define G8_STAGE_A(bh, half, kt) do { asm volatile("" : "+v"(offA)); \
    _Pragma("unroll") for (int _i = 0; _i < 2; ++_i) \
      __builtin_amdgcn_global_load_lds((const unsigned*)(A + (offA + (unsigned)(((half) * 128 + _i * 64) * lda + (kt) * 64))), \
        (unsigned*)(pS + (bh) * 16384 + _i * 8192), 16, 0, 0); } while (0)
#define G8_STAGE_B(bh, half, kt) do { asm volatile("" : "+v"(offB)); \
    _Pragma("unroll") for (int _i = 0; _i < 2; ++_i) \
      __builtin_amdgcn_global_load_lds((const unsigned*)(Bt + (offB + (unsigned)(((half) * 128 + _i * 64) * ldb + (kt) * 64))), \
        (unsigned*)(pS + (4 + (bh)) * 16384 + _i * 8192), 16, 0, 0); } while (0)
#define G8_LDA(dst, bh) _Pragma("unroll") for (int m = 0; m < 4; ++m) _Pragma("unroll") for (int k = 0; k < 2; ++k) \
    dst[m][k] = *reinterpret_cast<const bf16x8*>(pA + (bh) * 16384 + (m * 2 + k) * 1024)
#define G8_LDB(dst, bh) _Pragma("unroll") for (int n = 0; n < 2; ++n) _Pragma("unroll") for (int k = 0; k < 2; ++k) \
    dst[n][k] = *reinterpret_cast<const bf16x8*>(pB + (bh) * 16384 + (n * 2 + k) * 1024)
#define G8_MMA(ai, bj, At_, Bt_) do { __builtin_amdgcn_s_setprio(1); \
    _Pragma("unroll") for (int m = 0; m < 4; ++m) _Pragma("unroll") for (int n = 0; n < 2; ++n) _Pragma("unroll") for (int k = 0; k < 2; ++k) \
      acc[ai][bj][m][n] = MFMA16(Bt_[n][k], At_[m][k], acc[ai][bj][m][n]); \
    __builtin_amdgcn_s_setprio(0); } while (0)
#define G8_WAIT_V(n) asm volatile("s_waitcnt vmcnt(" #n ")" ::: "memory")
#define G8_WAIT_L(n) asm volatile("s_waitcnt lgkmcnt(" #n ")" ::: "memory")
#define G8_BAR __builtin_amdgcn_s_barrier()
#define G8_SCHED __builtin_amdgcn_sched_barrier(0)
  bf16x8 At[4][2], B0[2][2], B1[2][2];
  const int nt = K / 64;
  G8_WAIT_V(0);
  G8_STAGE_B(0, 0, 0); G8_STAGE_A(0, 0, 0);
  G8_STAGE_B(1, 1, 0); G8_STAGE_A(1, 1, 0);
  if (wr == 1) G8_BAR;
  G8_WAIT_V(4); G8_BAR;
  G8_STAGE_B(2, 0, 1); G8_STAGE_A(2, 0, 1); G8_STAGE_B(3, 1, 1);
  G8_WAIT_V(6); G8_BAR;
  for (int t = 0; t < nt - 2; t += 2) {
    G8_LDB(B0, 0); G8_SCHED; G8_LDA(At, 0); G8_STAGE_A(3, 1, t + 1);
    G8_WAIT_L(8); G8_BAR; G8_WAIT_L(0); G8_MMA(0, 0, At, B0); G8_BAR; G8_SCHED;
    G8_LDB(B1, 1); G8_STAGE_B(0, 0, t + 2);
    G8_BAR; G8_WAIT_L(0); G8_MMA(0, 1, At, B1); G8_BAR;
    G8_LDA(At, 1); G8_STAGE_A(0, 0, t + 2);
    G8_BAR; G8_WAIT_L(0); G8_MMA(1, 0, At, B0); G8_BAR; G8_SCHED;
    G8_STAGE_B(1, 1, t + 2);
    G8_WAIT_V(6); G8_BAR; G8_MMA(1, 1, At, B1); G8_BAR;
    G8_LDB(B0, 2); G8_SCHED; G8_LDA(At, 2); G8_STAGE_A(1, 1, t + 2);
    G8_WAIT_L(8); G8_BAR; G8_WAIT_L(0); G8_MMA(0, 0, At, B0); G8_BAR; G8_SCHED;
    G8_LDB(B1, 3); G8_STAGE_B(2, 0, t + 3);
    G8_BAR; G8_WAIT_L(0); G8_MMA(0, 1, At, B1); G8_BAR;
    G8_LDA(At, 3); G8_STAGE_A(2, 0, t + 3);
    G8_BAR; G8_WAIT_L(0); G8_MMA(1, 0, At, B0); G8_BAR; G8_SCHED;
    G8_STAGE_B(3, 1, t + 3);
    G8_WAIT_V(6); G8_BAR; G8_MMA(1, 1, At, B1); G8_BAR;
  }
  { G8_LDB(B0, 0); G8_LDA(At, 0); G8_STAGE_A(3, 1, nt - 1);
    G8_BAR; G8_WAIT_L(0); G8_MMA(0, 0, At, B0); G8_BAR;
    G8_LDB(B1, 1); G8_BAR; G8_WAIT_L(0); G8_MMA(0, 1, At, B1); G8_BAR;
    G8_LDA(At, 1); G8_WAIT_V(4); G8_BAR; G8_WAIT_L(0); G8_MMA(1, 0, At, B0); G8_MMA(1, 1, At, B1); G8_BAR; }
  { G8_LDB(B0, 2); G8_LDA(At, 2); G8_WAIT_V(2); G8_BAR; G8_WAIT_L(0); G8_MMA(0, 0, At, B0); G8_BAR;
    G8_LDB(B1, 3); G8_WAIT_V(0); G8_BAR; G8_WAIT_L(0); G8_MMA(0, 1, At, B1); G8_BAR;
    G8_LDA(At, 3); G8_BAR; G8_WAIT_L(0); G8_MMA(1, 0, At, B0); G8_MMA(1, 1, At, B1); G8_BAR; }
  if (wr == 0) G8_BAR;
}
DI void xcd_tile(int it, int WG, int NWG, int NT, int& mt, int& nt) {
  int L = it;
  if (NWG == 256) L = (it - WG) + (WG & 7) * 32 + (WG >> 3);
  const int g = L / (8 * NT), idx = L - g * (8 * NT);
  mt = g * 8 + (idx & 7); nt = idx >> 3;
}
DI void zero_acc8p(f32x4 (&acc)[2][2][4][2]) {
#pragma unroll
  for (int a = 0; a < 2; ++a)
#pragma unroll
    for (int b = 0; b < 2; ++b)
#pragma unroll
      for (int m = 0; m < 4; ++m)
#pragma unroll
        for (int n = 0; n < 2; ++n) acc[a][b][m][n] = zero4();
}
DI void zero_acc8(f32x4 (&acc)[4][8]) {
#pragma unroll
  for (int i = 0; i < 4; ++i)
#pragma unroll
    for (int j = 0; j < 8; ++j) acc[i][j] = zero4();
}
template <int NI>
DI void zero_acc(f32x4 (&acc)[4][NI]) {
#pragma unroll
  for (int i = 0; i < 4; ++i)
#pragma unroll
    for (int j = 0; j < NI; ++j) acc[i][j] = zero4();
}

DI int conv_col(int n, int mode, int base) {
  if (mode == 0) return n + base;
  if (mode == 1) return n < 1536 ? n : n + 8;
  const int g = n >> 5, s = (n >> 4) & 1, i = n & 15;
  return s * DFF + g * 16 + i;
}
DI void conv_tile(const float* __restrict__ src, int ld, bf16_t* __restrict__ dst, int Kd, int k0, int n0, int mode, int base,
                  bf16_t* tile, int tid) {
  const int n4 = (tid & 15) * 4, kr = tid >> 4;
  const int col = conv_col(n0 + n4, mode, base);
#pragma unroll
  for (int i = 0; i < 4; ++i) {
    const int k = kr + 16 * i;
    const f32x4 v = *(const f32x4*)(src + (size_t)(k0 + k) * ld + col);
    tile[(n4 + 0) * LDT + k] = f2bf(v[0]);
    tile[(n4 + 1) * LDT + k] = f2bf(v[1]);
    tile[(n4 + 2) * LDT + k] = f2bf(v[2]);
    tile[(n4 + 3) * LDT + k] = f2bf(v[3]);
  }
  __syncthreads();
  const int kc = (tid & 7) * 8, nr = tid >> 3;
#pragma unroll
  for (int i = 0; i < 2; ++i) {
    const int n = nr + 32 * i;
    *(u32x4*)(dst + (size_t)(n0 + n) * Kd + k0 + kc) = *(const u32x4*)(tile + n * LDT + kc);
  }
  __syncthreads();
}

DI void conv_item(const Params& p, int l, int it, bf16_t* tile, int tid) {
  unsigned char* ws = p.ws;
  if (it < 1024) { conv_tile(p.w_in + (size_t)l * D_ * INC, INC, (bf16_t*)(ws + O_WP), 1024, (it & 15) * 64, (it >> 4) * 64, 1, 0, tile, tid); return; }
  it -= 1024;
  if (it < 768) { conv_tile(p.w_in + (size_t)l * D_ * INC, INC, (bf16_t*)(ws + O_WG), 1024, (it & 15) * 64, (it >> 4) * 64, 0, 4104, tile, tid); return; }
  it -= 768;
  if (it < 384) { const int b = it >> 7, r = it & 127;
    conv_tile(p.w_branch + (size_t)l * 1536 * 1024 + (size_t)b * 512 * 1024, 1024, (bf16_t*)(ws + O_WBR) + (size_t)b * 1024 * 512, 512, (r & 7) * 64, (r >> 3) * 64, 0, 0, tile, tid); return; }
  it -= 384;
  if (it < 1280) { const int w = it >> 8, r = it & 255;
    const float* src = (w == 0 ? p.w_out : w == 1 ? p.xq : w == 2 ? p.xk : w == 3 ? p.xv : p.xo) + (size_t)l * 1024 * 1024;
    bf16_t* dst = (bf16_t*)(ws + (w == 0 ? O_WOUT : w == 1 ? O_WXQ : w == 2 ? O_WXK : w == 3 ? O_WXV : O_WXO));
    conv_tile(src, 1024, dst, 1024, (r & 15) * 64, (r >> 4) * 64, 0, 0, tile, tid); return; }
  it -= 1280;
  if (it < 1408) { conv_tile(p.w_gate_up + (size_t)l * 1024 * 5632, 5632, (bf16_t*)(ws + O_WGU), 1024, (it & 15) * 64, (it >> 4) * 64, 2, 0, tile, tid); return; }
  it -= 1408;
  if (it < 704) { const int kt = it % 44, nt = it / 44;
    conv_tile(p.w_down + (size_t)l * DFF * 1024, 1024, (bf16_t*)(ws + O_WD), DFF, kt * 64, nt * 64, 0, 0, tile, tid); return; }
  it -= 704;
  conv_tile(p.s5_w_glu + (size_t)l * 512 * 512, 512, (bf16_t*)(ws + O_WGLU), 512, (it & 7) * 64, (it >> 3) * 64, 0, 0, tile, tid);
}
constexpr int N_CONV = 1024 + 768 + 384 + 1280 + 1408 + 704 + 64;

DI void norm_item(const float* __restrict__ X, const float* __restrict__ gain, bf16_t* __restrict__ Hout, int row0,
                  const float* wfft, float* __restrict__ logf_out, const float* __restrict__ fbias, int tid) {
  const int lane = tid & 63, wave = tid >> 6;
  f32x4 g4[4];
#pragma unroll
  for (int i = 0; i < 4; ++i) g4[i] = *(const f32x4*)(gain + i * 256 + lane * 4);
  for (int rr = 0; rr < 8; ++rr) {
    const int row = row0 + wave * 8 + rr;
    const float* xr = X + (size_t)row * 1024;
    f32x4 v[4];
    float ss = 0.f;
#pragma unroll
    for (int i = 0; i < 4; ++i) {
      v[i] = *(const f32x4*)(xr + i * 256 + lane * 4);
      ss += v[i][0] * v[i][0] + v[i][1] * v[i][1] + v[i][2] * v[i][2] + v[i][3] * v[i][3];
    }
    ss = wave_sum(ss);
    const float rs = rsqrtf(ss * (1.f / 1024.f) + EPS);
#pragma unroll
    for (int i = 0; i < 4; ++i) {
      v[i] = v[i] * rs * g4[i];
      store_bf4(Hout + (size_t)row * 1024 + i * 256 + lane * 4, v[i]);
    }
    if (wfft) {
      float mine = 0.f;
#pragma unroll
      for (int j = 0; j < 8; ++j) {
        float a = 0.f;
#pragma unroll
        for (int i = 0; i < 4; ++i) {
          const f32x4 w = *(const f32x4*)(wfft + j * 1024 + i * 256 + lane * 4);
          a += v[i][0] * w[0] + v[i][1] * w[1] + v[i][2] * w[2] + v[i][3] * w[3];
        }
        a = wave_sum(a);
        mine = (lane == j) ? a : mine;
      }
      if (lane < 8) {
        const float xv = mine + fbias[lane];
        logf_out[(size_t)row * 8 + lane] = fminf(xv, 0.f) - __logf(1.f + __expf(-fabsf(xv)));
      }
    }
  }
}

DI void cumsum_item(const Params& p, int bh, unsigned char* smem, int tid) {
  const float* logf = (const float*)(p.ws + O_LOGF);
  float* cum = (float*)(p.ws + O_CUM);
  float* part = (float*)smem;
  const int b = bh >> 3, h = bh & 7;
  const float* src = logf + ((size_t)b * S_ + tid * 64) * 8 + h;
  float s = 0.f;
  for (int j = 0; j < 64; ++j) s += src[j * 8];
  part[tid] = s;
  __syncthreads();
  float pre = 0.f;
  for (int j = 0; j < tid; ++j) pre += part[j];
  float* dst = cum + (size_t)bh * S_ + tid * 64;
  for (int j = 0; j < 64; ++j) { pre += src[j * 8]; dst[j] = pre * LOG2E; }
  __syncthreads();
}

constexpr int LDK = 72;
DI void fox_item(const Params& p, int fox_l, int idx, unsigned char* smem, int tid) {
  bf16_t* QK = (bf16_t*)(p.ws + O_QK);
  const int bh = idx & 15, qt = 63 - (idx >> 4);
  const int b = bh >> 3, h = bh & 7;
  const int lane = tid & 63, wave = tid >> 6, fr = lane & 15, fq = lane >> 4;
  const float* cum = (const float*)(p.ws + O_CUM) + (size_t)bh * S_;
  const size_t rowbase = (size_t)b * S_;
  const int q0 = qt * 256 + wave * 32;
  bf16_t* sK = (bf16_t*)smem;
  bf16_t* sV = sK + 2 * 64 * LDK;
  float* sC = (float*)(sV + 2 * 64 * LDK);
  int* sF = (int*)(sC + 128);
  float qkb;
  {
    float gq = fabsf(p.fox_qnorm[fox_l * 64 + lane]), gk = fabsf(p.fox_knorm[fox_l * 64 + lane]);
#pragma unroll
    for (int mm = 32; mm >= 1; mm >>= 1) { gq = fmaxf(gq, __shfl_xor(gq, mm, 64)); gk = fmaxf(gk, __shfl_xor(gk, mm, 64)); }
    qkb = 8.f * LOG2E * gq * gk * 1.02f + 40.f;
  }
  bool wdone = false;
  bf16x8 qf[2][2];
  float cq[2];
#pragma unroll
  for (int f = 0; f < 2; ++f) {
    const int q = q0 + f * 16 + fr;
    const bf16_t* qp = QK + (rowbase + q) * 4096 + h * 64;
    qf[f][0] = *(const bf16x8*)(qp + fq * 8);
    qf[f][1] = *(const bf16x8*)(qp + 32 + fq * 8);
    cq[f] = cum[q];
  }
  f32x4 o[4][2];
#pragma unroll
  for (int d = 0; d < 4; ++d) { o[d][0] = zero4(); o[d][1] = zero4(); }
  float m[2] = {-1e30f, -1e30f}, ls[2] = {0.f, 0.f};
  const int ntiles = (qt + 1) * 4;
  const int kkey = tid >> 3, kdc = (tid & 7) * 8;
  const int vkey = tid & 63, vdc = (tid >> 6) * 8;
  const bf16_t* gk = QK + (rowbase + kkey) * 4096 + 512 + h * 64 + kdc;
  const bf16_t* gv = QK + (rowbase + vkey) * 4096 + 1024 + h * 64 + vdc;
  u32x4 rk0[1], rv0[1], rk1[1], rv1[1];
  float rc0 = 0.f, rc1 = 0.f;
  auto gload = [&](int t, u32x4 (&rk)[1], u32x4 (&rv)[1], float& rc) {
    const size_t off = (size_t)t * 64 * 4096;
    rk[0] = *(const u32x4*)(gk + off);
    rv[0] = *(const u32x4*)(gv + off);
    if (tid < 64) rc = cum[t * 64 + tid];
  };
  auto sstore = [&](int buf, const u32x4 (&rk)[1], const u32x4 (&rv)[1], float rc) {
    {
      *(u32x4*)(sK + buf * 64 * LDK + kkey * LDK + kdc) = rk[0];
      bf16_t* vp = sV + buf * 64 * LDK + vdc * LDK + vkey;
      const u32x4 w = rv[0];
      vp[0 * LDK] = (bf16_t)(w.x & 0xffff); vp[1 * LDK] = (bf16_t)(w.x >> 16);
      vp[2 * LDK] = (bf16_t)(w.y & 0xffff); vp[3 * LDK] = (bf16_t)(w.y >> 16);
      vp[4 * LDK] = (bf16_t)(w.z & 0xffff); vp[5 * LDK] = (bf16_t)(w.z >> 16);
      vp[6 * LDK] = (bf16_t)(w.w & 0xffff); vp[7 * LDK] = (bf16_t)(w.w >> 16);
    }
    if (tid < 64) sC[buf * 64 + tid] = rc;
  };
  auto compute = [&](int t, int buf) {
    const int k0 = t * 64;
    if (!wdone && k0 <= q0 + 31) {
      const float cnew = sC[buf * 64 + 63];
      const bool prune = (qkb + cq[0] - cnew < m[0]) && (qkb + cq[1] - cnew < m[1]);
      if (__builtin_amdgcn_ballot_w64(!prune) == 0ull) wdone = true;
    }
    if (!wdone && k0 <= q0 + 31) {
      const bf16_t* bK = sK + buf * 64 * LDK;
      const bf16_t* bV = sV + buf * 64 * LDK;
      const float* bC = sC + buf * 64;
      f32x4 s[4][2];
#pragma unroll
      for (int kf = 0; kf < 4; ++kf) {
        s[kf][0] = (f32x4){cq[0], cq[0], cq[0], cq[0]};
        s[kf][1] = (f32x4){cq[1], cq[1], cq[1], cq[1]};
      }
#pragma unroll
      for (int kk = 0; kk < 2; ++kk)
#pragma unroll
        for (int kf = 0; kf < 4; ++kf) {
          const bf16x8 a = *(const bf16x8*)(bK + (kf * 16 + fr) * LDK + kk * 32 + fq * 8);
          s[kf][0] = MFMA16(a, qf[0][kk], s[kf][0]);
          s[kf][1] = MFMA16(a, qf[1][kk], s[kf][1]);
        }
#pragma unroll
      for (int kf = 0; kf < 4; ++kf) {
        const f32x4 ck = *(const f32x4*)(bC + kf * 16 + fq * 4);
        s[kf][0] -= ck; s[kf][1] -= ck;
      }
      if (k0 + 63 > q0) {
#pragma unroll
        for (int kf = 0; kf < 4; ++kf)
#pragma unroll
          for (int f = 0; f < 2; ++f)
#pragma unroll
            for (int r = 0; r < 4; ++r) {
              const int key = k0 + kf * 16 + fq * 4 + r, q = q0 + f * 16 + fr;
              if (key > q) s[kf][f][r] = -1e30f;
            }
      }
#pragma unroll
      for (int f = 0; f < 2; ++f) {
        float mx = -1e30f;
#pragma unroll
        for (int kf = 0; kf < 4; ++kf)
#pragma unroll
          for (int r = 0; r < 4; ++r) mx = fmaxf(mx, s[kf][f][r]);
        mx = fmaxf(mx, __shfl_xor(mx, 16, 64));
        mx = fmaxf(mx, __shfl_xor(mx, 32, 64));
        const float mn = fmaxf(m[f], mx);
        const float alpha = ex2(m[f] - mn);
        m[f] = mn;
        float ps = 0.f;
#pragma unroll
        for (int kf = 0; kf < 4; ++kf)
#pragma unroll
          for (int r = 0; r < 4; ++r) { const float pv = ex2(s[kf][f][r] - mn); s[kf][f][r] = pv; ps += pv; }
        ls[f] = ls[f] * alpha + ps;
#pragma unroll
        for (int d = 0; d < 4; ++d) o[d][f] *= alpha;
      }
#pragma unroll
      for (int ss = 0; ss < 2; ++ss) {
        const bf16x8 pb0 = pack8(s[2 * ss][0], s[2 * ss + 1][0]);
        const bf16x8 pb1 = pack8(s[2 * ss][1], s[2 * ss + 1][1]);
#pragma unroll
        for (int d = 0; d < 4; ++d) {
          const bf16_t* vp = bV + (d * 16 + fr) * LDK + ss * 32 + fq * 4;
          const bf16x8 a = cat4(*(const bf16x4*)vp, *(const bf16x4*)(vp + 16));
          o[d][0] = MFMA16(a, pb0, o[d][0]);
          o[d][1] = MFMA16(a, pb1, o[d][1]);
        }
      }
    }
  };
  const int T = ntiles;
  gload(T - 1, rk0, rv0, rc0); sstore(0, rk0, rv0, rc0);
  gload(T - 2, rk0, rv0, rc0);
  if (T > 2) gload(T - 3, rk1, rv1, rc1);
  if (tid < 16) sF[tid] = 0;
  __syncthreads();
  int par = 0;
  for (int i = 0; i < T; i += 2) {
    if (i > 0) {
      int alldone = 1;
#pragma unroll
      for (int w = 0; w < 8; ++w) alldone &= sF[par * 8 + w];
      par ^= 1;
      if (alldone) break;
    }
    compute(T - 1 - i, 0);
    sstore(1, rk0, rv0, rc0);
    if (i + 3 < T) gload(T - 4 - i, rk0, rv0, rc0);
    __syncthreads();
    compute(T - 2 - i, 1);
    if (i + 2 < T) sstore(0, rk1, rv1, rc1);
    if (i + 4 < T) gload(T - 5 - i, rk1, rv1, rc1);
    if (lane == 0) sF[par * 8 + wave] = wdone ? 1 : 0;
    __syncthreads();
  }
  __syncthreads();
#pragma unroll
  for (int f = 0; f < 2; ++f) {
    float l = ls[f];
    l += __shfl_xor(l, 16, 64); l += __shfl_xor(l, 32, 64);
    const float inv = 1.f / l;
    const int q = q0 + f * 16 + fr;
    bf16_t* op = (bf16_t*)(p.ws + O_YF) + (rowbase + q) * 512 + h * 64 + fq * 4;
#pragma unroll
    for (int d = 0; d < 4; ++d) store_bf4(op + d * 16, o[d][f] * inv);
  }
}

DI float hg_lb_of(const Params& p, int l, int c) {
  float e[NL], tot = 0.f, part = 0.f;
  float mx = -1e30f;
#pragma unroll
  for (int j = 0; j < NL; ++j) { e[j] = p.hg_lb[j * 512 + c]; mx = fmaxf(mx, e[j]); }
#pragma unroll
  for (int j = 0; j < NL; ++j) { e[j] = __expf(e[j] - mx); tot += e[j]; part += (j >= 1 && j <= l) ? e[j] : 0.f; }
  return part / tot;
}
DI void hg_gate(float z, float lb, float& logf, float& key) {
  const float e = __expf(-fabsf(z));
  const float r = __builtin_amdgcn_rcpf(1.f + e);
  const float sg = (z >= 0.f ? 1.f : e) * r;
  const float sn = (z >= 0.f ? e : 1.f) * r;
  const float f = lb + (1.f - lb) * sg;
  key = (1.f - lb) * sn;
  logf = __logf(fmaxf(f, 1e-30f));
}
constexpr int LDH = 136;
DI void hg1_item(const Params& p, int l, int ch, unsigned char* smem, int tid) {
  const bf16_t* QK = (const bf16_t*)(p.ws + O_QK);
  bf16_t* SB = (bf16_t*)(p.ws + O_SBUF) + (size_t)ch * 16384;
  float* DC = (float*)(p.ws + O_DCY) + (size_t)ch * 128;
  const int bhh = ch >> 8, c = ch & 255, b = bhh >> 2, h = bhh & 3;
  const size_t row0 = (size_t)b * S_ + c * 64;
  bf16_t* kT = (bf16_t*)smem;
  bf16_t* vT = kT + 128 * LDK;
  float* sums = (float*)(vT + 128 * LDK);
  const int k = tid & 127, th = tid >> 7;
  const float lb = hg_lb_of(p, l, h * 128 + k);
  float lf[32], ky[32];
  float loc = 0.f;
  const bf16_t* zf = QK + (row0 + th * 32) * 4096 + 5 * 512 + h * 128 + k;
#pragma unroll
  for (int j = 0; j < 32; ++j) {
    hg_gate(bf2f(zf[(size_t)j * 4096]), lb, lf[j], ky[j]);
    loc += lf[j];
  }
  sums[th * 128 + k] = loc;
  {
    const int s = tid & 63, vc = (tid >> 6) * 8;
#pragma unroll
    for (int i = 0; i < 4; ++i) {
      const u32x4 w = *(const u32x4*)(QK + (row0 + s) * 4096 + 6 * 512 + h * 128 + vc + 32 * i);
      bf16_t* vp = vT + (vc + 32 * i) * LDK + s;
      vp[0 * LDK] = (bf16_t)(w.x & 0xffff); vp[1 * LDK] = (bf16_t)(w.x >> 16);
      vp[2 * LDK] = (bf16_t)(w.y & 0xffff); vp[3 * LDK] = (bf16_t)(w.y >> 16);
      vp[4 * LDK] = (bf16_t)(w.z & 0xffff); vp[5 * LDK] = (bf16_t)(w.z >> 16);
      vp[6 * LDK] = (bf16_t)(w.w & 0xffff); vp[7 * LDK] = (bf16_t)(w.w >> 16);
    }
  }
  __syncthreads();
  const float s0 = sums[k], s1 = sums[128 + k];
  const float total = s0 + s1;
  float run = th ? s0 : 0.f;
#pragma unroll
  for (int j = 0; j < 32; ++j) {
    run += lf[j];
    kT[k * LDK + th * 32 + j] = f2bf(ky[j] * __expf(total - run));
  }
  if (th == 0) DC[k] = __expf(total);
  __syncthreads();
  const int lane = tid & 63, wave = tid >> 6, fr = lane & 15, fq = lane >> 4;
  f32x4 acc[2][8];
#pragma unroll
  for (int i = 0; i < 2; ++i)
#pragma unroll
    for (int j = 0; j < 8; ++j) acc[i][j] = zero4();
#pragma unroll
  for (int ss = 0; ss < 2; ++ss) {
    bf16x8 bk[2];
#pragma unroll
    for (int i = 0; i < 2; ++i) bk[i] = *(const bf16x8*)(kT + (wave * 32 + i * 16 + fr) * LDK + ss * 32 + fq * 8);
#pragma unroll
    for (int j = 0; j < 8; ++j) {
      const bf16x8 av = *(const bf16x8*)(vT + (j * 16 + fr) * LDK + ss * 32 + fq * 8);
#pragma unroll
      for (int i = 0; i < 2; ++i) acc[i][j] = MFMA16(bk[i], av, acc[i][j]);
    }
  }
#pragma unroll
  for (int i = 0; i < 2; ++i)
#pragma unroll
    for (int j = 0; j < 8; ++j) store_bf4(SB + (j * 16 + fr) * 128 + wave * 32 + i * 16 + fq * 4, acc[i][j]);
  __syncthreads();
}
DI void hg2_item(const Params& p, int item, int tid) {
  const int gid = item * 256 + tid;
  const int bhh = gid >> 13, rem = gid & 8191, v = rem >> 6, k2 = (rem & 63) * 2;
  bf16_t* SB = (bf16_t*)(p.ws + O_SBUF) + (size_t)bhh * 256 * 16384 + v * 128 + k2;
  const float* DC = (const float*)(p.ws + O_DCY) + (size_t)bhh * 256 * 128 + k2;
  float s0 = 0.f, s1 = 0.f;
  for (int c = 0; c < 256; c += 8) {
    unsigned tmp[8]; f32x2 dc[8];
#pragma unroll
    for (int u = 0; u < 8; ++u) { tmp[u] = *(const unsigned*)(SB + (size_t)(c + u) * 16384); dc[u] = *(const f32x2*)(DC + (c + u) * 128); }
#pragma unroll
    for (int u = 0; u < 8; ++u) {
      *(unsigned*)(SB + (size_t)(c + u) * 16384) = pk2(s0, s1);
      s0 = dc[u][0] * s0 + bflo(tmp[u]);
      s1 = dc[u][1] * s1 + bfhi(tmp[u]);
    }
  }
}
DI void hg3_item(const Params& p, int l, int ch, unsigned char* smem, int tid) {
  bf16_t* QK = (bf16_t*)(p.ws + O_QK);
  const bf16_t* SB = (const bf16_t*)(p.ws + O_SBUF) + (size_t)ch * 16384;
  const int bhh = ch >> 8, c = ch & 255, b = bhh >> 2, h = bhh & 3;
  const size_t row0 = (size_t)b * S_ + c * 64;
  bf16_t* qi = (bf16_t*)smem;
  bf16_t* qa = qi + 64 * LDH;
  bf16_t* ka = qa + 64 * LDH;
  bf16_t* vT = ka + 64 * LDH;
  float* sums = (float*)(vT + 128 * LDK);
  const int k = tid & 127, th = tid >> 7;
  const float lb = hg_lb_of(p, l, h * 128 + k);
  float lf[32], ky[32];
  float loc = 0.f;
  const bf16_t* zf = QK + (row0 + th * 32) * 4096 + 5 * 512 + h * 128 + k;
  const bf16_t* zq = QK + (row0 + th * 32) * 4096 + 4 * 512 + h * 128 + k;
#pragma unroll
  for (int j = 0; j < 32; ++j) {
    hg_gate(bf2f(zf[(size_t)j * 4096]), lb, lf[j], ky[j]);
    loc += lf[j];
  }
  if (th == 0) sums[k] = loc;
  {
    const int s = tid & 63, vc = (tid >> 6) * 8;
#pragma unroll
    for (int i = 0; i < 4; ++i) {
      const u32x4 w = *(const u32x4*)(QK + (row0 + s) * 4096 + 6 * 512 + h * 128 + vc + 32 * i);
      bf16_t* vp = vT + (vc + 32 * i) * LDK + s;
      vp[0 * LDK] = (bf16_t)(w.x & 0xffff); vp[1 * LDK] = (bf16_t)(w.x >> 16);
      vp[2 * LDK] = (bf16_t)(w.y & 0xffff); vp[3 * LDK] = (bf16_t)(w.y >> 16);
      vp[4 * LDK] = (bf16_t)(w.z & 0xffff); vp[5 * LDK] = (bf16_t)(w.z >> 16);
      vp[6 * LDK] = (bf16_t)(w.w & 0xffff); vp[7 * LDK] = (bf16_t)(w.w >> 16);
    }
  }
  __syncthreads();
  {
    const float bmid = sums[k];
    float run = th ? bmid : 0.f;
#pragma unroll
    for (int j = 0; j < 32; ++j) {
      run += lf[j];
      const float qz = bf2f(zq[(size_t)j * 4096]);
      const float qs = qz * sigmoidf_(qz);
      const int t = th * 32 + j;
      const float er = __expf(run - bmid);
      qi[t * LDH + k] = f2bf(qs * __expf(run));
      qa[t * LDH + k] = f2bf(qs * er);
      ka[t * LDH + k] = f2bf(ky[j] * __expf(bmid - run));
    }
  }
  __syncthreads();
  const int lane = tid & 63, wave = tid >> 6, fr = lane & 15, fq = lane >> 4;
  const int tcol = wave * 16 + fr;
  f32x4 sc[4];
#pragma unroll
  for (int i = 0; i < 4; ++i) sc[i] = zero4();
#pragma unroll
  for (int kk = 0; kk < 4; ++kk) {
    const bf16x8 bq = *(const bf16x8*)(qa + tcol * LDH + kk * 32 + fq * 8);
#pragma unroll
    for (int sf = 0; sf < 4; ++sf) {
      const bf16x8 a = *(const bf16x8*)(ka + (sf * 16 + fr) * LDH + kk * 32 + fq * 8);
      sc[sf] = MFMA16(a, bq, sc[sf]);
    }
  }
#pragma unroll
  for (int sf = 0; sf < 4; ++sf)
#pragma unroll
    for (int r = 0; r < 4; ++r) { const int s = sf * 16 + fq * 4 + r; if (s > tcol) sc[sf][r] = 0.f; }
  f32x4 o[8];
#pragma unroll
  for (int j = 0; j < 8; ++j) o[j] = zero4();
#pragma unroll
  for (int ss = 0; ss < 2; ++ss) {
    const bf16x8 pb = pack8(sc[2 * ss], sc[2 * ss + 1]);
#pragma unroll
    for (int j = 0; j < 8; ++j) {
      const bf16_t* vp = vT + (j * 16 + fr) * LDK + ss * 32 + fq * 4;
      const bf16x8 a = cat4(*(const bf16x4*)vp, *(const bf16x4*)(vp + 16));
      o[j] = MFMA16(a, pb, o[j]);
    }
  }
#pragma unroll
  for (int kk = 0; kk < 4; ++kk) {
    const bf16x8 bq = *(const bf16x8*)(qi + tcol * LDH + kk * 32 + fq * 8);
#pragma unroll
    for (int j = 0; j < 8; ++j) {
      const bf16x8 a = *(const bf16x8*)(SB + (j * 16 + fr) * 128 + kk * 32 + fq * 8);
      o[j] = MFMA16(a, bq, o[j]);
    }
  }
  float ss = 0.f;
#pragma unroll
  for (int j = 0; j < 8; ++j) ss += o[j][0] * o[j][0] + o[j][1] * o[j][1] + o[j][2] * o[j][2] + o[j][3] * o[j][3];
  ss += __shfl_xor(ss, 16, 64); ss += __shfl_xor(ss, 32, 64);
  const float rs = rsqrtf(ss * (1.f / 128.f) + EPS);
  const float* gn = p.hg_onorm + l * 128;
  const size_t row = row0 + tcol;
#pragma unroll
  for (int j = 0; j < 8; ++j) {
    const int v = j * 16 + fq * 4;
    const f32x4 g4 = *(const f32x4*)(gn + v);
    const u32x2 gw = *(const u32x2*)(QK + row * 4096 + 7 * 512 + h * 128 + v);
    f32x4 gg = {bflo(gw.x), bfhi(gw.x), bflo(gw.y), bfhi(gw.y)};
    f32x4 y;
#pragma unroll
    for (int r = 0; r < 4; ++r) y[r] = o[j][r] * rs * g4[r] * gg[r] * sigmoidf_(gg[r]);
    store_bf4(QK + row * 4096 + 4 * 512 + h * 128 + v, y);
  }
  __syncthreads();
}

struct S5c { float abr, abi; };
DI void s5_consts(const Params& p, int l, int g, int lp, float& abr, float& abi, float& cfr, float& cfi) {
  const float dt = __expf(p.s5_log_dt[l * 32 + g]);
  const float ar = p.s5_a_re[(l * 32 + g) * 64 + lp], ai = p.s5_a_im[(l * 32 + g) * 64 + lp];
  const float mag = __expf(dt * ar);
  const float x = dt * ai;
  const float kq = rintf(x * 0.636619772367581343f);
  float r = fmaf(-kq, 1.5707855225e+00f, x);
  r = fmaf(-kq, 1.0804334124e-05f, r);
  const float r2 = r * r;
  const float sp_ = r + r * r2 * (-1.6666667163e-01f + r2 * (8.3333337680e-03f + r2 * (-1.9841270114e-04f + r2 * 2.7557314297e-06f)));
  const float cp_ = 1.f - 0.5f * r2 + r2 * r2 * (4.1666667908e-02f + r2 * (-1.3888889225e-03f + r2 * (2.4801587642e-05f + r2 * -2.7557314297e-07f)));
  const int nq = ((int)kq) & 3;
  const float sn = (nq == 0) ? sp_ : (nq == 1) ? cp_ : (nq == 2) ? -sp_ : -cp_;
  const float cs = (nq == 0) ? cp_ : (nq == 1) ? -sp_ : (nq == 2) ? -cp_ : sp_;
  abr = mag * cs; abi = mag * sn;
  const float inv = 1.f / (ar * ar + ai * ai);
  const float nr = abr - 1.f, ni = abi;
  cfr = (nr * ar + ni * ai) * inv;
  cfi = (ni * ar - nr * ai) * inv;
}
DI void s5tab_item(const Params& p, int l, int item, int tid) {
  const int gid = item * 256 + tid;
  const int g = gid >> 6, lp = gid & 63;
  float abr, abi, cfr, cfi;
  s5_consts(p, l, g, lp, abr, abi, cfr, cfi);
  float* tb = (float*)(p.ws + O_S5T) + (size_t)gid * 36;
  const float* br = p.s5_b_re + ((size_t)(l * 32 + g) * 64 + lp) * 16;
  const float* bi = p.s5_b_im + ((size_t)(l * 32 + g) * 64 + lp) * 16;
  *(f32x4*)tb = (f32x4){abr, abi, 0.f, 0.f};
#pragma unroll
  for (int q = 0; q < 4; ++q) {
    const f32x4 r4 = *(const f32x4*)(br + q * 4), i4 = *(const f32x4*)(bi + q * 4);
    *(f32x4*)(tb + 4 + q * 4) = cfr * r4 - cfi * i4;
    *(f32x4*)(tb + 20 + q * 4) = cfr * i4 + cfi * r4;
  }
}
DI void s5_load(const Params& p, int g, int lane, float& abr, float& abi, float (&bbr)[16], float (&bbi)[16]) {
  const float* tb = (const float*)(p.ws + O_S5T) + (size_t)(g * 64 + lane) * 36;
  const f32x4 a = *(const f32x4*)tb;
  abr = a[0]; abi = a[1];
#pragma unroll
  for (int q = 0; q < 4; ++q) {
    const f32x4 r4 = *(const f32x4*)(tb + 4 + q * 4), i4 = *(const f32x4*)(tb + 20 + q * 4);
#pragma unroll
    for (int e = 0; e < 4; ++e) { bbr[q * 4 + e] = r4[e]; bbi[q * 4 + e] = i4[e]; }
  }
}
DI void s5a_item(const Params& p, int l, int item, unsigned char* smem, int tid) {
  const bf16_t* QK = (const bf16_t*)(p.ws + O_QK);
  f32x2* E = (f32x2*)(p.ws + O_S5E);
  const int lane = tid & 63, wave = tid >> 6;
  const int wi = item * 4 + wave;
  const int g = wi & 31, c = (wi >> 5) & 127, b = wi >> 12;
  float* us = (float*)smem + wave * 2048;
  float abr, abi;
  float bbr[16], bbi[16];
  s5_load(p, g, lane, abr, abi, bbr, bbi);
  const size_t row0 = (size_t)b * S_ + c * 128;
#pragma unroll
  for (int i = 0; i < 2; ++i) {
    const int t = lane + 64 * i;
    const bf16_t* up = QK + (row0 + t) * 4096 + 3 * 512 + g * 16;
    const u32x4 w0 = *(const u32x4*)up, w1 = *(const u32x4*)(up + 8);
    float* d = us + t * 16;
    *(f32x4*)(d + 0) = (f32x4){bflo(w0.x), bfhi(w0.x), bflo(w0.y), bfhi(w0.y)};
    *(f32x4*)(d + 4) = (f32x4){bflo(w0.z), bfhi(w0.z), bflo(w0.w), bfhi(w0.w)};
    *(f32x4*)(d + 8) = (f32x4){bflo(w1.x), bfhi(w1.x), bflo(w1.y), bfhi(w1.y)};
    *(f32x4*)(d + 12) = (f32x4){bflo(w1.z), bfhi(w1.z), bflo(w1.w), bfhi(w1.w)};
  }
  __syncthreads();
  float hr = 0.f, hi = 0.f;
  float ur[2][16];
#pragma unroll
  for (int i = 0; i < 2; ++i)
#pragma unroll
    for (int h = 0; h < 16; ++h) ur[i][h] = us[(lane + 64 * i) * 16 + h];
#pragma unroll
  for (int i = 0; i < 2; ++i) {
    for (int tt = 0; tt < 64; ++tt) {
      float dr = 0.f, di = 0.f;
#pragma unroll
      for (int h = 0; h < 16; ++h) {
        const float uh = __int_as_float(__builtin_amdgcn_readlane(__float_as_int(ur[i][h]), tt));
        dr += bbr[h] * uh; di += bbi[h] * uh;
      }
      const float nr = abr * hr - abi * hi + dr;
      const float ni = abr * hi + abi * hr + di;
      hr = nr; hi = ni;
    }
  }
  E[((size_t)(b * 32 + g) * 128 + c) * 64 + lane] = (f32x2){hr, hi};
  __syncthreads();
}
DI void s5b_item(const Params& p, int l, int item, int tid) {
  const int gid = item * 256 + tid;
  const int bg = gid >> 6, lp = gid & 63, g = bg & 31;
  const f32x4 ab4 = *(const f32x4*)((const float*)(p.ws + O_S5T) + (size_t)(g * 64 + lp) * 36);
  const float abr = ab4[0], abi = ab4[1];
  float pr = abr, pi = abi;
#pragma unroll
  for (int i = 0; i < 7; ++i) { const float nr = pr * pr - pi * pi, ni = 2.f * pr * pi; pr = nr; pi = ni; }
  f32x2* E = (f32x2*)(p.ws + O_S5E) + (size_t)bg * 128 * 64 + lp;
  float hr = 0.f, hi = 0.f;
  for (int c = 0; c < 128; c += 8) {
    f32x2 e[8];
#pragma unroll
    for (int u = 0; u < 8; ++u) e[u] = E[(size_t)(c + u) * 64];
#pragma unroll
    for (int u = 0; u < 8; ++u) {
      E[(size_t)(c + u) * 64] = (f32x2){hr, hi};
      const float nr = pr * hr - pi * hi + e[u][0];
      const float ni = pr * hi + pi * hr + e[u][1];
      hr = nr; hi = ni;
    }
  }
}
DI float gelu_tanh(float y) {
  const float u = 1.5957691216057308f * (y + 0.044715f * y * y * y);
  return y * __builtin_amdgcn_rcpf(1.f + __expf(-u));
}
DI void s5c_item(const Params& p, int l, int item, unsigned char* smem, int tid) {
  bf16_t* QK = (bf16_t*)(p.ws + O_QK);
  const f32x2* E = (const f32x2*)(p.ws + O_S5E);
  const int lane = tid & 63, wave = tid >> 6, fr = lane & 15, fq = lane >> 4;
  const int wi = item * 4 + wave;
  const int g = wi & 31, c = (wi >> 5) & 127, b = wi >> 12;
  float* us = (float*)smem + wave * 2048;
  bf16_t* Hs = (bf16_t*)(smem + 32768) + wave * 16 * LDH;
  float abr, abi;
  float bbr[16], bbi[16];
  s5_load(p, g, lane, abr, abi, bbr, bbi);
  bf16x8 cop[4];
#pragma unroll
  for (int kk = 0; kk < 4; ++kk) {
    const int k = kk * 32 + fq * 8;
    const float* src = (k < 64 ? p.s5_c_re : p.s5_c_im) + ((size_t)(l * 32 + g) * 16 + fr) * 64 + (k & 63);
    const float sg = k < 64 ? 1.f : -1.f;
    const f32x4 a = *(const f32x4*)src * sg, bq = *(const f32x4*)(src + 4) * sg;
    cop[kk] = pack8(a, bq);
  }
  const f32x4 dsk = *(const f32x4*)(p.s5_d + l * 512 + g * 16 + fq * 4);
  const size_t row0 = (size_t)b * S_ + c * 128;
#pragma unroll
  for (int i = 0; i < 2; ++i) {
    const int t = lane + 64 * i;
    const bf16_t* up = QK + (row0 + t) * 4096 + 3 * 512 + g * 16;
    const u32x4 w0 = *(const u32x4*)up, w1 = *(const u32x4*)(up + 8);
    float* d = us + t * 16;
    *(f32x4*)(d + 0) = (f32x4){bflo(w0.x), bfhi(w0.x), bflo(w0.y), bfhi(w0.y)};
    *(f32x4*)(d + 4) = (f32x4){bflo(w0.z), bfhi(w0.z), bflo(w0.w), bfhi(w0.w)};
    *(f32x4*)(d + 8) = (f32x4){bflo(w1.x), bfhi(w1.x), bflo(w1.y), bfhi(w1.y)};
    *(f32x4*)(d + 12) = (f32x4){bflo(w1.z), bfhi(w1.z), bflo(w1.w), bfhi(w1.w)};
  }
  const f32x2 e0 = E[((size_t)(b * 32 + g) * 128 + c) * 64 + lane];
  float hr = e0[0], hi = e0[1];
  __syncthreads();
  float ur[2][16];
#pragma unroll
  for (int i = 0; i < 2; ++i)
#pragma unroll
    for (int h = 0; h < 16; ++h) ur[i][h] = us[(lane + 64 * i) * 16 + h];
#pragma unroll
  for (int ih = 0; ih < 2; ++ih)
  for (int tb4 = 0; tb4 < 4; ++tb4) {
    const int tb = ih * 4 + tb4;
    for (int tt = 0; tt < 16; ++tt) {
      const int ln = tb4 * 16 + tt;
      float dr = 0.f, di = 0.f;
#pragma unroll
      for (int h = 0; h < 16; ++h) {
        const float uh = __int_as_float(__builtin_amdgcn_readlane(__float_as_int(ur[ih][h]), ln));
        dr += bbr[h] * uh; di += bbi[h] * uh;
      }
      const float nr = abr * hr - abi * hi + dr;
      const float ni = abr * hi + abi * hr + di;
      hr = nr; hi = ni;
      Hs[tt * LDH + lane] = f2bf(hr);
      Hs[tt * LDH + 64 + lane] = f2bf(hi);
    }
    __syncthreads();
    f32x4 y = zero4();
#pragma unroll
    for (int kk = 0; kk < 4; ++kk) {
      const bf16x8 hb = *(const bf16x8*)(Hs + fr * LDH + kk * 32 + fq * 8);
      y = MFMA16(cop[kk], hb, y);
    }
    const int t = tb * 16 + fr;
    const f32x4 u4 = *(const f32x4*)(us + t * 16 + fq * 4);
    f32x4 z;
#pragma unroll
    for (int r = 0; r < 4; ++r) z[r] = gelu_tanh(y[r] + dsk[r] * u4[r]);
    store_bf4(QK + (row0 + t) * 4096 + 3 * 512 + g * 16 + fq * 4, z);
    __syncthreads();
  }
}

DI void kxnorm_item(const Params& p, int l, int item, int tid) {
  const int lane = tid & 63, wave = tid >> 6;
  const int wi = item * 4 + wave;
  const int row = wi >> 2, hd = wi & 3;
  const float* src = (const float*)(p.ws + O_KXR) + (size_t)row * 1024 + hd * 256 + lane * 4;
  const f32x4 v = *(const f32x4*)src;
  float ss = v[0] * v[0] + v[1] * v[1] + v[2] * v[2] + v[3] * v[3];
  ss = wave_sum(ss);
  const float rs = rsqrtf(ss * (1.f / 256.f) + EPS);
  const f32x4 g4 = *(const f32x4*)(p.x_knorm + l * 256 + lane * 4);
  store_bf4((bf16_t*)(p.ws + O_KXN) + (size_t)row * 1024 + hd * 256 + lane * 4, v * rs * g4);
}
constexpr int LDX = 264;
DI void xattn_item(const Params& p, int l, int item, unsigned char* smem, int tid) {
  const bf16_t* QX = (const bf16_t*)(p.ws + O_QK);
  bf16_t* OX = (bf16_t*)(p.ws + O_QK) + (size_t)T_ * 1024;
  const bf16_t* KXN = (const bf16_t*)(p.ws + O_KXN);
  const bf16_t* VXT = (const bf16_t*)(p.ws + O_VXT);
  const int lane = tid & 63, wave = tid >> 6, fr = lane & 15, fq = lane >> 4;
  const int hd = item & 3, rt = item >> 2;
  const int b = rt >> 7;
  const size_t row = (size_t)rt * 128 + wave * 16 + fr;
  bf16_t* sT = (bf16_t*)smem;
  bf16x8 qf[8];
  {
    float ss = 0.f;
    f32x4 qa[8][2];
    const bf16_t* qp = QX + row * 1024 + hd * 256 + fq * 8;
#pragma unroll
    for (int kk = 0; kk < 8; ++kk) {
      const u32x4 w = *(const u32x4*)(qp + kk * 32);
      qa[kk][0] = (f32x4){bflo(w.x), bfhi(w.x), bflo(w.y), bfhi(w.y)};
      qa[kk][1] = (f32x4){bflo(w.z), bfhi(w.z), bflo(w.w), bfhi(w.w)};
#pragma unroll
      for (int e = 0; e < 4; ++e) ss += qa[kk][0][e] * qa[kk][0][e] + qa[kk][1][e] * qa[kk][1][e];
    }
    ss += __shfl_xor(ss, 16, 64); ss += __shfl_xor(ss, 32, 64);
    const float rs = rsqrtf(ss * (1.f / 256.f) + EPS) * (0.0625f * LOG2E);
    const float* gq = p.x_qnorm + l * 256 + fq * 8;
#pragma unroll
    for (int kk = 0; kk < 8; ++kk) {
      const f32x4 g0 = *(const f32x4*)(gq + kk * 32), g1 = *(const f32x4*)(gq + kk * 32 + 4);
      qf[kk] = pack8(qa[kk][0] * rs * g0, qa[kk][1] * rs * g1);
    }
  }
  f32x4 s[16];
#pragma unroll
  for (int i = 0; i < 16; ++i) s[i] = zero4();
#pragma unroll
  for (int jt = 0; jt < 4; ++jt) {
#pragma unroll
    for (int i = 0; i < 4; ++i) {
      const int cidx = tid + 512 * i, key = cidx >> 5, dc = (cidx & 31) * 8;
      *(u32x4*)(sT + key * LDX + dc) = *(const u32x4*)(KXN + ((size_t)b * 256 + jt * 64 + key) * 1024 + hd * 256 + dc);
    }
    __syncthreads();
#pragma unroll
    for (int kk = 0; kk < 8; ++kk)
#pragma unroll
      for (int mf = 0; mf < 4; ++mf) {
        const bf16x8 a = *(const bf16x8*)(sT + (mf * 16 + fr) * LDX + kk * 32 + fq * 8);
        s[jt * 4 + mf] = MFMA16(a, qf[kk], s[jt * 4 + mf]);
      }
    __syncthreads();
  }
  float mx = -1e30f;
#pragma unroll
  for (int i = 0; i < 16; ++i)
#pragma unroll
    for (int r = 0; r < 4; ++r) mx = fmaxf(mx, s[i][r]);
  mx = fmaxf(mx, __shfl_xor(mx, 16, 64)); mx = fmaxf(mx, __shfl_xor(mx, 32, 64));
  float ls = 0.f;
#pragma unroll
  for (int i = 0; i < 16; ++i)
#pragma unroll
    for (int r = 0; r < 4; ++r) { const float pv = ex2(s[i][r] - mx); s[i][r] = pv; ls += pv; }
  ls += __shfl_xor(ls, 16, 64); ls += __shfl_xor(ls, 32, 64);
  const float inv = 1.f / ls;
  bf16x8 pp[8];
#pragma unroll
  for (int i = 0; i < 8; ++i) pp[i] = pack8(s[2 * i], s[2 * i + 1]);
  f32x4 o[16];
#pragma unroll
  for (int i = 0; i < 16; ++i) o[i] = zero4();
#pragma unroll
  for (int jt = 0; jt < 4; ++jt) {
#pragma unroll
    for (int i = 0; i < 4; ++i) {
      const int cidx = tid + 512 * i, d = cidx >> 3, mc = (cidx & 7) * 8;
      *(u32x4*)(sT + d * LDK + mc) = *(const u32x4*)(VXT + ((size_t)b * 1024 + hd * 256 + d) * 256 + jt * 64 + mc);
    }
    __syncthreads();
#pragma unroll
    for (int ss = 0; ss < 2; ++ss) {
      const bf16x8 pb = pp[jt * 2 + ss];
#pragma unroll
      for (int df = 0; df < 16; ++df) {
        const bf16_t* vp = sT + (df * 16 + fr) * LDK + ss * 32 + fq * 4;
        const bf16x8 a = cat4(*(const bf16x4*)vp, *(const bf16x4*)(vp + 16));
        o[df] = MFMA16(a, pb, o[df]);
      }
    }
    __syncthreads();
  }
  bf16_t* op = OX + row * 1024 + hd * 256 + fq * 4;
#pragma unroll
  for (int df = 0; df < 16; ++df) store_bf4(op + df * 16, o[df] * inv);
}

__global__ void __launch_bounds__(512, 2) mega(Params p, int ph_lo, int ph_hi, int coop) {
  __shared__ __attribute__((aligned(16))) unsigned char smem_all[147456];
#ifdef DIAG_ZERO
  if (ph_lo == 0) {
    u32x4* w4 = (u32x4*)p.ws;
    const u32x4 z4 = {0u, 0u, 0u, 0u};
    for (size_t i = (size_t)blockIdx.x * 256 + threadIdx.x; i < O_END / 16; i += (size_t)gridDim.x * 256) w4[i] = z4;
    u32x4* o4 = (u32x4*)p.out;
    for (size_t i = (size_t)blockIdx.x * 256 + threadIdx.x; i < (size_t)T_ * 1024 / 4; i += (size_t)gridDim.x * 256) o4[i] = z4;
    for (int i = threadIdx.x; i < 73728 / 16; i += 256) ((u32x4*)smem)[i] = z4;
    __syncthreads();
    if (coop) cg::this_grid().sync();
  }
#endif
  if (coop) {
    if (blockIdx.x == 0 && threadIdx.x == 0) __hip_atomic_store((unsigned*)(p.ws + O_BAR), 0u, __ATOMIC_RELAXED, __HIP_MEMORY_SCOPE_AGENT);
    cg::this_grid().sync();
  }
  for (int ph = ph_lo; ph < ph_hi; ++ph) {
#ifdef REP_MASK
    const int nrep = ((REP_MASK >> (ph % NPH)) & 1) ? 2 : 1;
#else
    const int nrep = 1;
#endif
    for (int rep = 0; rep < nrep; ++rep) {
    int tid = threadIdx.x, G = gridDim.x * 2, bid = blockIdx.x * 2;
    asm volatile("" : "+v"(tid));
    asm volatile("" : "+s"(G));
    const int sub = __builtin_amdgcn_readfirstlane(tid >> 8);
    tid &= 255;
    bid += sub;
    unsigned char* smem = smem_all + sub * 73728;
    int t8 = threadIdx.x, WG = blockIdx.x, NWG = gridDim.x;
    asm volatile("" : "+v"(t8));
    asm volatile("" : "+s"(WG));
    asm volatile("" : "+s"(NWG));
    const int wr8 = t8 >> 7, wc8 = (t8 >> 6) & 1;
    const int wr2 = t8 >> 8, wc4 = (t8 >> 6) & 3;
    const int lane = tid & 63, wave = tid >> 6, wr = wave >> 1, wc = wave & 1, fr = lane & 15, fq = lane >> 4;
    unsigned char* ws = p.ws;
    asm volatile("" : "+s"(ws));
    bf16_t* HB = (bf16_t*)(ws + O_HB);
    bf16_t* QK = (bf16_t*)(ws + O_QK);
    const int l = ph / NPH;
#ifdef ONLY_SP
    const int sp = ONLY_SP;
#else
    const int sp = ph % NPH;
#endif
    const float* xin = (l == 0) ? p.x : p.out;
    if (sp == 0) {
      float* wfft = (float*)smem;
      bf16_t* ctile = (bf16_t*)(smem + 32768);
      {
        const float* wsrc = p.w_in + (size_t)l * D_ * INC + 1536;
        for (int i = tid; i < 2048; i += 256) {
          const int k = i >> 1, j4 = (i & 1) * 4;
          const f32x4 v = *(const f32x4*)(wsrc + (size_t)k * INC + j4);
          wfft[(j4 + 0) * 1024 + k] = v[0]; wfft[(j4 + 1) * 1024 + k] = v[1];
          wfft[(j4 + 2) * 1024 + k] = v[2]; wfft[(j4 + 3) * 1024 + k] = v[3];
        }
        __syncthreads();
      }
      const int total = 1024 + 16 + N_CONV + 8;
      for (int it = bid; it < total; it += G) {
        if (it < 1024) norm_item(xin, p.norm_mix + l * 1024, HB, it * 32, wfft, (float*)(ws + O_LOGF), p.fox_fbias + l * 8, tid);
        else if (it < 1040) norm_item(p.mem, p.norm_mem + l * 1024, (bf16_t*)(ws + O_MEMN), (it - 1024) * 32, nullptr, nullptr, nullptr, tid);
        else if (it < 1040 + N_CONV) conv_item(p, l, it - 1040, ctile, tid);
        else s5tab_item(p, l, it - 1040 - N_CONV, tid);
      }
    } else if (sp == 1) {
      for (int it = bid; it < 16 + 64; it += G) {
        if (it < 16) { cumsum_item(p, it, smem, tid); continue; }
        f32x4 acc[4][4];
        zero_acc<4>(acc);
        const int t = it - 16, nt = t & 15, mt = t >> 4;
        const int m0 = mt * 128, n0 = (nt & 7) * 128;
        const bf16_t* W = (const bf16_t*)(ws + (nt < 8 ? O_WXK : O_WXV));
        gemm_core<4>((const bf16_t*)(ws + O_MEMN) + (size_t)m0 * 1024, 1024, W + (size_t)n0 * 1024, 1024, 1024, acc, smem, tid);
        if (nt < 8) {
          float* KXR = (float*)(ws + O_KXR);
#pragma unroll
          for (int mi = 0; mi < 4; ++mi) {
            const size_t row = m0 + wr * 64 + mi * 16 + fr;
#pragma unroll
            for (int ni = 0; ni < 4; ++ni) *(f32x4*)(KXR + row * 1024 + n0 + wc * 64 + ni * 16 + fq * 4) = acc[mi][ni];
          }
        } else {
          bf16_t* VXT = (bf16_t*)(ws + O_VXT);
#pragma unroll
          for (int mi = 0; mi < 4; ++mi) {
            const int row = m0 + wr * 64 + mi * 16 + fr, bb = row >> 8, mm = row & 255;
#pragma unroll
            for (int ni = 0; ni < 4; ++ni)
#pragma unroll
              for (int r = 0; r < 4; ++r) VXT[((size_t)bb * 1024 + n0 + wc * 64 + ni * 16 + fq * 4 + r) * 256 + mm] = f2bf(acc[mi][ni][r]);
          }
        }
      }
      for (int it = WG; it < 2048; it += NWG) {
        int nt, mt; xcd_tile(it, WG, NWG, 16, mt, nt);
        const int m0 = mt * 256, n0 = nt * 256;
        f32x4 acc[2][2][4][2];
        zero_acc8p(acc);
        gemm8p(HB + (size_t)m0 * 1024, 1024, (const bf16_t*)(ws + O_WP) + (size_t)n0 * 1024, 1024, 1024, acc, smem_all, t8);
        const int slot = n0 >> 9;
        if (slot < 2) {
          const float* gn = (slot == 0 ? p.fox_qnorm : p.fox_knorm) + l * 64 + (wc4 & 1) * 32 + fq * 4;
          const float scl = slot == 0 ? 0.125f * LOG2E : 1.f;
          float* xs = (float*)smem_all;
          const int wid8 = t8 >> 6;
          float part[2][2][4];
#pragma unroll
          for (int ai = 0; ai < 2; ++ai)
#pragma unroll
            for (int bj = 0; bj < 2; ++bj)
#pragma unroll
              for (int m = 0; m < 4; ++m) {
                float ss = 0.f;
#pragma unroll
                for (int n = 0; n < 2; ++n)
#pragma unroll
                  for (int r = 0; r < 4; ++r) ss += acc[ai][bj][m][n][r] * acc[ai][bj][m][n][r];
                ss += __shfl_xor(ss, 16, 64); ss += __shfl_xor(ss, 32, 64);
                part[ai][bj][m] = ss;
                if (fq == 0) xs[(wid8 * 16 + (ai * 2 + bj) * 4 + m) * 16 + fr] = ss;
              }
          __syncthreads();
          const f32x4 g0 = *(const f32x4*)gn, g1 = *(const f32x4*)(gn + 16);
#pragma unroll
          for (int ai = 0; ai < 2; ++ai)
#pragma unroll
            for (int m = 0; m < 4; ++m) {
              const size_t row = m0 + ai * 128 + wr2 * 64 + m * 16 + fr;
#pragma unroll
              for (int bj = 0; bj < 2; ++bj) {
                const float tot = part[ai][bj][m] + xs[((wid8 ^ 1) * 16 + (ai * 2 + bj) * 4 + m) * 16 + fr];
                const float rs = rsqrtf(tot * (1.f / 64.f) + EPS) * scl;
                bf16_t* dst = QK + row * 4096 + n0 + bj * 128 + wc4 * 32 + fq * 4;
                store_bf4(dst, acc[ai][bj][m][0] * rs * g0);
                store_bf4(dst + 16, acc[ai][bj][m][1] * rs * g1);
              }
            }
          __syncthreads();
        } else {
#pragma unroll
          for (int ai = 0; ai < 2; ++ai)
#pragma unroll
            for (int m = 0; m < 4; ++m) {
              const size_t row = m0 + ai * 128 + wr2 * 64 + m * 16 + fr;
#pragma unroll
              for (int bj = 0; bj < 2; ++bj)
#pragma unroll
                for (int n = 0; n < 2; ++n) store_bf4(QK + row * 4096 + n0 + bj * 128 + wc4 * 32 + n * 16 + fq * 4, acc[ai][bj][m][n]);
            }
        }
      }
    } else if (sp == 2) {
      const int total = 2048 + 2048 + 512;
      for (int it = bid; it < total; it += G) {
        if (it < 2048) hg1_item(p, l, it, smem, tid);
        else if (it < 4096) s5a_item(p, l, it - 2048, smem, tid);
        else kxnorm_item(p, l, it - 4096, tid);
      }
    } else if (sp == 3) {
      const int total = 256 + 16;
      for (int it = bid; it < total; it += G) {
        if (it < 256) hg2_item(p, it, tid);
        else s5b_item(p, l, it - 256, tid);
      }
    } else if (sp == 4) {
      for (int it = WG; it < 1024; it += NWG) {
        int idx = it;
        const int j = it / NWG;
        if ((j & 1) && (j + 1) * NWG <= 1024) idx = j * NWG + (NWG - 1 - (it - j * NWG));
        fox_item(p, l, idx, smem_all, t8);
      }
      for (int it = bid; it < 4096; it += G) {
        if (it < 2048) hg3_item(p, l, it, smem, tid);
        else s5c_item(p, l, it - 2048, smem, tid);
      }
    } else if (sp == 5) {
      const float* bg = p.s5_b_glu + l * 512;
      for (int it = WG; it < 256; it += NWG) {
        int nt, mt; xcd_tile(it, WG, NWG, 2, mt, nt);
        const int m0 = mt * 256, n0 = nt * 256;
        f32x4 acc[2][2][4][2];
        zero_acc8p(acc);
        gemm8p(QK + (size_t)m0 * 4096 + 3 * 512, 4096, (const bf16_t*)(ws + O_WGLU) + (size_t)n0 * 512, 512, 512, acc, smem_all, t8);
#pragma unroll
        for (int ai = 0; ai < 2; ++ai)
#pragma unroll
          for (int m = 0; m < 4; ++m) {
            const size_t row = m0 + ai * 128 + wr2 * 64 + m * 16 + fr;
#pragma unroll
            for (int bj = 0; bj < 2; ++bj)
#pragma unroll
              for (int n = 0; n < 2; ++n) {
                const int col = n0 + bj * 128 + wc4 * 32 + n * 16 + fq * 4;
                const f32x4 b4 = *(const f32x4*)(bg + col);
                const u32x2 zw = *(const u32x2*)(QK + row * 4096 + 3 * 512 + col);
                const f32x4 z = {bflo(zw.x), bfhi(zw.x), bflo(zw.y), bfhi(zw.y)};
                f32x4 y;
#pragma unroll
                for (int r = 0; r < 4; ++r) y[r] = z[r] * sigmoidf_(acc[ai][bj][m][n][r] + b4[r]);
                store_bf4(QK + row * 4096 + 5 * 512 + col, y);
              }
          }
      }
    } else if (sp == 6) {
      for (int it = WG; it < 512; it += NWG) {
        int nt, mt; xcd_tile(it, WG, NWG, 4, mt, nt);
        const int m0 = mt * 256, n0 = nt * 256;
#pragma unroll 1
        for (int br = 0; br < 3; ++br) {
          f32x4 acc[2][2][4][2];
          zero_acc8p(acc);
          gemm8p(HB + (size_t)m0 * 1024, 1024, (const bf16_t*)(ws + O_WG) + (size_t)(br * 1024 + n0) * 1024, 1024, 1024, acc, smem_all, t8);
          { int tq = threadIdx.x; asm volatile("" : "+v"(tq));
          u32x4* gs = (u32x4*)(ws + O_GS) + ((size_t)WG * 512 + tq) * 16;
#pragma unroll
          for (int ai = 0; ai < 2; ++ai)
#pragma unroll
            for (int bj = 0; bj < 2; ++bj)
#pragma unroll
              for (int m = 0; m < 4; ++m) {
                u32x4 g;
                g.x = pk2(sigmoidf_(acc[ai][bj][m][0][0]), sigmoidf_(acc[ai][bj][m][0][1]));
                g.y = pk2(sigmoidf_(acc[ai][bj][m][0][2]), sigmoidf_(acc[ai][bj][m][0][3]));
                g.z = pk2(sigmoidf_(acc[ai][bj][m][1][0]), sigmoidf_(acc[ai][bj][m][1][1]));
                g.w = pk2(sigmoidf_(acc[ai][bj][m][1][2]), sigmoidf_(acc[ai][bj][m][1][3]));
                gs[(ai * 2 + bj) * 4 + m] = g;
              }
          }
          zero_acc8p(acc);
          const bf16_t* Ab = br == 0 ? (const bf16_t*)(ws + O_YF) + (size_t)m0 * 512 : QK + (size_t)m0 * 4096 + (br == 1 ? 5 : 4) * 512;
          gemm8p(Ab, br == 0 ? 512 : 4096, (const bf16_t*)(ws + O_WBR) + (size_t)br * 1024 * 512 + (size_t)n0 * 512, 512, 512, acc, smem_all, t8);
          int tq2 = threadIdx.x; asm volatile("" : "+v"(tq2));
          const u32x4* gs = (const u32x4*)(ws + O_GS) + ((size_t)WG * 512 + tq2) * 16;
          const int fr_e = tq2 & 15, fq_e = (tq2 >> 4) & 3, wr_e = tq2 >> 8, wc_e = (tq2 >> 6) & 3;
#pragma unroll
          for (int ai = 0; ai < 2; ++ai)
#pragma unroll
            for (int m = 0; m < 4; ++m) {
              const size_t row = m0 + ai * 128 + wr_e * 64 + m * 16 + fr_e;
#pragma unroll
              for (int bj = 0; bj < 2; ++bj) {
                const u32x4 g = gs[(ai * 2 + bj) * 4 + m];
                bf16_t* dst = QK + row * 4096 + 512 + n0 + bj * 128 + wc_e * 32 + fq_e * 4;
                f32x4 v0 = acc[ai][bj][m][0] * (f32x4){bflo(g.x), bfhi(g.x), bflo(g.y), bfhi(g.y)};
                f32x4 v1 = acc[ai][bj][m][1] * (f32x4){bflo(g.z), bfhi(g.z), bflo(g.w), bfhi(g.w)};
                if (br > 0) {
                  const u32x2 o0 = *(const u32x2*)dst, o1 = *(const u32x2*)(dst + 16);
                  v0 += (f32x4){bflo(o0.x), bfhi(o0.x), bflo(o0.y), bfhi(o0.y)};
                  v1 += (f32x4){bflo(o1.x), bfhi(o1.x), bflo(o1.y), bfhi(o1.y)};
                }
                store_bf4(dst, v0);
                store_bf4(dst + 16, v1);
              }
            }
        }
      }
    } else if (sp == 7 || sp == 11 || sp == 14) {
      const bf16_t* A; int lda, K; const bf16_t* W;
      const float* rin;
      if (sp == 7) { A = QK + 512; lda = 4096; K = 1024; W = (const bf16_t*)(ws + O_WOUT); rin = xin; }
      else if (sp == 11) { A = QK + (size_t)T_ * 1024; lda = 1024; K = 1024; W = (const bf16_t*)(ws + O_WXO); rin = p.out; }
      else { A = QK; lda = DFF; K = DFF; W = (const bf16_t*)(ws + O_WD); rin = p.out; }
      for (int it = WG; it < 512; it += NWG) {
        int nt, mt; xcd_tile(it, WG, NWG, 4, mt, nt);
        const int m0 = mt * 256, n0 = nt * 256;
        f32x4 acc[2][2][4][2];
        zero_acc8p(acc);
        gemm8p(A + (size_t)m0 * lda, lda, W + (size_t)n0 * K, K, K, acc, smem_all, t8);
#pragma unroll
        for (int ai = 0; ai < 2; ++ai)
#pragma unroll
          for (int m = 0; m < 4; ++m) {
            const size_t row = m0 + ai * 128 + wr2 * 64 + m * 16 + fr;
#pragma unroll
            for (int bj = 0; bj < 2; ++bj)
#pragma unroll
              for (int n = 0; n < 2; ++n) {
                const size_t o = row * 1024 + n0 + bj * 128 + wc4 * 32 + n * 16 + fq * 4;
                *(f32x4*)(p.out + o) = *(const f32x4*)(rin + o) + acc[ai][bj][m][n];
              }
          }
      }
    } else if (sp == 8 || sp == 12) {
      const float* gn = (sp == 8 ? p.norm_x : p.norm_ffn) + l * 1024;
      for (int it = bid; it < 1024; it += G) norm_item(p.out, gn, HB, it * 32, nullptr, nullptr, nullptr, tid);
    } else if (sp == 9) {
      for (int it = WG; it < 512; it += NWG) {
        int nt, mt; xcd_tile(it, WG, NWG, 4, mt, nt);
        const int m0 = mt * 256, n0 = nt * 256;
        f32x4 acc[2][2][4][2];
        zero_acc8p(acc);
        gemm8p(HB + (size_t)m0 * 1024, 1024, (const bf16_t*)(ws + O_WXQ) + (size_t)n0 * 1024, 1024, 1024, acc, smem_all, t8);
#pragma unroll
        for (int ai = 0; ai < 2; ++ai)
#pragma unroll
          for (int m = 0; m < 4; ++m) {
            const size_t row = m0 + ai * 128 + wr2 * 64 + m * 16 + fr;
#pragma unroll
            for (int bj = 0; bj < 2; ++bj)
#pragma unroll
              for (int n = 0; n < 2; ++n) store_bf4(QK + row * 1024 + n0 + bj * 128 + wc4 * 32 + n * 16 + fq * 4, acc[ai][bj][m][n]);
          }
      }
    } else if (sp == 10) {
      for (int it = WG; it < 1024; it += NWG) xattn_item(p, l, it, smem_all, t8);
    } else if (sp == 13) {
      for (int it = WG; it < 128 * 22; it += NWG) {
        int nt, mt; xcd_tile(it, WG, NWG, 22, mt, nt);
        const int m0 = mt * 256, n0 = nt * 256;
        f32x4 acc[2][2][4][2];
        zero_acc8p(acc);
        gemm8p(HB + (size_t)m0 * 1024, 1024, (const bf16_t*)(ws + O_WGU) + (size_t)n0 * 1024, 1024, 1024, acc, smem_all, t8);
#pragma unroll
        for (int ai = 0; ai < 2; ++ai)
#pragma unroll
          for (int m = 0; m < 4; ++m) {
            const size_t row = m0 + ai * 128 + wr2 * 64 + m * 16 + fr;
#pragma unroll
            for (int bj = 0; bj < 2; ++bj) {
              f32x4 y;
#pragma unroll
              for (int r = 0; r < 4; ++r) { const float a = acc[ai][bj][m][0][r]; y[r] = a * sigmoidf_(a) * acc[ai][bj][m][1][r]; }
              store_bf4(QK + row * DFF + nt * 128 + bj * 64 + wc4 * 16 + fq * 4, y);
            }
          }
      }
    }
    }
    if (coop && ph + 1 < ph_hi) {
      unsigned* bar = (unsigned*)(p.ws + O_BAR);
      __builtin_amdgcn_fence(__ATOMIC_RELEASE, "workgroup");
      asm volatile("s_waitcnt vmcnt(0)" ::: "memory");
      __syncthreads();
      if (threadIdx.x == 0) {
        const unsigned target = (unsigned)(ph - ph_lo + 1) * gridDim.x;
        __builtin_amdgcn_fence(__ATOMIC_RELEASE, "agent");
        __hip_atomic_fetch_add(bar, 1u, __ATOMIC_RELAXED, __HIP_MEMORY_SCOPE_AGENT);
        while (__hip_atomic_load(bar, __ATOMIC_RELAXED, __HIP_MEMORY_SCOPE_AGENT) < target) __builtin_amdgcn_s_sleep(1);
        __builtin_amdgcn_fence(__ATOMIC_ACQUIRE, "agent");
      }
      __syncthreads();
    }
#ifdef EXTRA_SYNC
    if (coop) for (int e = 0; e < EXTRA_SYNC; ++e) cg::this_grid().sync();
#endif
  }
}

extern "C" void kernel_launch(void* const* d_in, const int* in_sizes, int n_in, void* d_out, int out_size, void* d_ws,
                              size_t ws_size, hipStream_t stream) {
  Params p{};
  const float** pp = (const float**)&p;
  for (int i = 0; i < 32; ++i) pp[i] = (const float*)d_in[i];
  p.out = (float*)d_out;
  p.ws = (unsigned char*)d_ws;
  if (ws_size < O_END) return;
  static int grid = 0;
  if (!grid) {
    int dev = 0, cus = 0, per_cu = 0;
    hipGetDevice(&dev);
    hipDeviceGetAttribute(&cus, hipDeviceAttributeMultiprocessorCount, dev);
    hipOccupancyMaxActiveBlocksPerMultiprocessor(&per_cu, mega, 512, 0);
    if (per_cu < 1) per_cu = 1;
    if (per_cu > 1) per_cu = 1;
    grid = cus * per_cu;
  }
#if MK_MULTI
  for (int ph = 0; ph < NL * NPH; ++ph) hipLaunchKernelGGL(mega, dim3(grid), dim3(512), 0, stream, p, ph, ph + 1, 0);
#else
  int lo = 0, hi = NL * NPH, coop = 1;
  void* args[] = {&p, &lo, &hi, &coop};
  hipError_t e = hipLaunchCooperativeKernel((void*)mega, dim3(grid), dim3(512), args, 0, stream);
  if (e != hipSuccess) fprintf(stderr, "cooperative launch failed: %s (grid %d)\n", hipGetErrorString(e), grid);
#endif
}
```

```cpp
#include <hip/hip_runtime.h>
#include <hip/hip_cooperative_groups.h>
#include <cstdio>
#include <cstdint>
namespace cg = cooperative_groups;

#ifndef MK_MULTI
#define MK_MULTI 0
#endif

typedef unsigned short bf16_t;
typedef short bf16x8 __attribute__((ext_vector_type(8)));
typedef short bf16x4 __attribute__((ext_vector_type(4)));
typedef float f32x4 __attribute__((ext_vector_type(4)));
typedef float f32x2 __attribute__((ext_vector_type(2)));
typedef __bf16 hbf2 __attribute__((ext_vector_type(2)));
typedef unsigned u32x4 __attribute__((ext_vector_type(4)));
typedef unsigned u32x2 __attribute__((ext_vector_type(2)));

#define DI __device__ __forceinline__
#define MFMA16(a, b, c) __builtin_amdgcn_mfma_f32_16x16x32_bf16((a), (b), (c), 0, 0, 0)

constexpr int T_ = 32768, S_ = 16384, D_ = 1024, NL = 4;
constexpr int INC = 7176, DFF = 2816;
constexpr float LOG2E = 1.4426950408889634f;
constexpr float EPS = 1e-6f;
constexpr int NPH = 15;

constexpr size_t O_WP = 0;
constexpr size_t O_WG = O_WP + 4096ull * 1024 * 2;
constexpr size_t O_WBR = O_WG + 3072ull * 1024 * 2;
constexpr size_t O_WOUT = O_WBR + 3ull * 1024 * 512 * 2;
constexpr size_t O_WXQ = O_WOUT + 1024ull * 1024 * 2;
constexpr size_t O_WXK = O_WXQ + 1024ull * 1024 * 2;
constexpr size_t O_WXV = O_WXK + 1024ull * 1024 * 2;
constexpr size_t O_WXO = O_WXV + 1024ull * 1024 * 2;
constexpr size_t O_WGU = O_WXO + 1024ull * 1024 * 2;
constexpr size_t O_WD = O_WGU + 5632ull * 1024 * 2;
constexpr size_t O_WGLU = O_WD + 1024ull * 2816 * 2;
constexpr size_t O_HB = O_WGLU + 512ull * 512 * 2;
constexpr size_t O_QK = O_HB + (size_t)T_ * 1024 * 2;
constexpr size_t O_SBUF = O_QK + (size_t)T_ * 4096 * 2;
constexpr size_t O_DCY = O_SBUF + 2048ull * 128 * 128 * 2;
constexpr size_t O_LOGF = O_DCY + 2048ull * 128 * 4;
constexpr size_t O_CUM = O_LOGF + (size_t)T_ * 8 * 4;
constexpr size_t O_S5E = O_CUM + (size_t)T_ * 8 * 4;
constexpr size_t O_MEMN = O_S5E + 2ull * 32 * 128 * 64 * 8;
constexpr size_t O_KXR = O_MEMN + 512ull * 1024 * 2;
constexpr size_t O_KXN = O_KXR + 512ull * 1024 * 4;
constexpr size_t O_VXT = O_KXN + 512ull * 1024 * 2;
constexpr size_t O_S5T = O_VXT + 512ull * 1024 * 2;
constexpr size_t O_YF = O_S5T + 32ull * 64 * 36 * 4;
constexpr size_t O_BAR = O_YF + (size_t)T_ * 512 * 2;
constexpr size_t O_GS = O_BAR + 256;
constexpr size_t O_END = O_GS + 256ull * 512 * 256;

struct Params {
  const float *x, *mem, *norm_mix, *w_in, *fox_fbias, *fox_qnorm, *fox_knorm, *s5_a_re, *s5_a_im, *s5_b_re, *s5_b_im,
      *s5_c_re, *s5_c_im, *s5_d, *s5_log_dt, *s5_w_glu, *s5_b_glu, *hg_lb, *hg_onorm, *w_branch, *w_out, *norm_x,
      *norm_mem, *xq, *xk, *xv, *xo, *x_qnorm, *x_knorm, *norm_ffn, *w_gate_up, *w_down;
  float* out;
  unsigned char* ws;
};

DI unsigned pk2(float a, float b) {
  f32x2 v = {a, b};
  hbf2 r = __builtin_convertvector(v, hbf2);
  return __builtin_bit_cast(unsigned, r);
}
DI bf16_t f2bf(float a) { return (bf16_t)(pk2(a, 0.f) & 0xffffu); }
DI float bf2f(bf16_t v) { return __uint_as_float((unsigned)v << 16); }
DI float bflo(unsigned u) { return __uint_as_float(u << 16); }
DI float bfhi(unsigned u) { return __uint_as_float(u & 0xffff0000u); }
DI float wave_sum(float v) {
  v += __shfl_xor(v, 32, 64); v += __shfl_xor(v, 16, 64); v += __shfl_xor(v, 8, 64);
  v += __shfl_xor(v, 4, 64); v += __shfl_xor(v, 2, 64); v += __shfl_xor(v, 1, 64);
  return v;
}
DI float sigmoidf_(float x) { return __builtin_amdgcn_rcpf(1.f + __expf(-x)); }
DI float ex2(float x) { return __builtin_amdgcn_exp2f(x); }
DI f32x4 zero4() { return (f32x4){0.f, 0.f, 0.f, 0.f}; }
DI void store_bf4(bf16_t* p, f32x4 v) { u32x2 w; w.x = pk2(v[0], v[1]); w.y = pk2(v[2], v[3]); *(u32x2*)p = w; }
DI bf16x8 pack8(f32x4 a, f32x4 b) {
  u32x4 w; w.x = pk2(a[0], a[1]); w.y = pk2(a[2], a[3]); w.z = pk2(b[0], b[1]); w.w = pk2(b[2], b[3]);
  return __builtin_bit_cast(bf16x8, w);
}
DI bf16x8 cat4(bf16x4 lo, bf16x4 hi) { return __builtin_shufflevector(lo, hi, 0, 1, 2, 3, 4, 5, 6, 7); }

constexpr int LDT = 72;
template <int NI>
DI void gemm_core(const bf16_t* __restrict__ A, int lda, const bf16_t* __restrict__ Bt, int ldb, int K,
                  f32x4 (&acc)[4][NI], unsigned char* smem, int tid) {
  constexpr int BN = 32 * NI;
  constexpr int NB = BN / 32;
  bf16_t* sA = (bf16_t*)smem;
  bf16_t* sB = sA + 2 * 128 * LDT;
  const int lane = tid & 63, wave = tid >> 6, wr = wave >> 1, wc = wave & 1, fr = lane & 15, fq = lane >> 4;
  const int lrow = tid >> 3, lkc = (tid & 7) * 8;
  u32x4 ra[4], rb[NB];
  const int nk = K >> 6;
  const bf16_t* ga = A + (size_t)lrow * lda + lkc;
  const bf16_t* gb = Bt + (size_t)lrow * ldb + lkc;
#pragma unroll
  for (int i = 0; i < 4; ++i) ra[i] = *(const u32x4*)(ga + (size_t)(32 * i) * lda);
#pragma unroll
  for (int i = 0; i < NB; ++i) rb[i] = *(const u32x4*)(gb + (size_t)(32 * i) * ldb);
#pragma unroll
  for (int i = 0; i < 4; ++i) *(u32x4*)(sA + (lrow + 32 * i) * LDT + lkc) = ra[i];
#pragma unroll
  for (int i = 0; i < NB; ++i) *(u32x4*)(sB + (lrow + 32 * i) * LDT + lkc) = rb[i];
  __syncthreads();
  for (int kt = 0; kt < nk; ++kt) {
    const int buf = kt & 1;
    if (kt + 1 < nk) {
#pragma unroll
      for (int i = 0; i < 4; ++i) ra[i] = *(const u32x4*)(ga + (size_t)(32 * i) * lda + (kt + 1) * 64);
#pragma unroll
      for (int i = 0; i < NB; ++i) rb[i] = *(const u32x4*)(gb + (size_t)(32 * i) * ldb + (kt + 1) * 64);
    }
    const bf16_t* pa = sA + buf * 128 * LDT + (wr * 64 + fr) * LDT + fq * 8;
    const bf16_t* pb = sB + buf * BN * LDT + (wc * 16 * NI + fr) * LDT + fq * 8;
#pragma unroll
    for (int kk = 0; kk < 2; ++kk) {
      bf16x8 af[4], bfr[NI];
#pragma unroll
      for (int i = 0; i < 4; ++i) af[i] = *(const bf16x8*)(pa + i * 16 * LDT + kk * 32);
#pragma unroll
      for (int i = 0; i < NI; ++i) bfr[i] = *(const bf16x8*)(pb + i * 16 * LDT + kk * 32);
#pragma unroll
      for (int mi = 0; mi < 4; ++mi)
#pragma unroll
        for (int ni = 0; ni < NI; ++ni) acc[mi][ni] = MFMA16(bfr[ni], af[mi], acc[mi][ni]);
    }
    if (kt + 1 < nk) {
      const int nb = buf ^ 1;
#pragma unroll
      for (int i = 0; i < 4; ++i) *(u32x4*)(sA + nb * 128 * LDT + (lrow + 32 * i) * LDT + lkc) = ra[i];
#pragma unroll
      for (int i = 0; i < NB; ++i) *(u32x4*)(sB + nb * BN * LDT + (lrow + 32 * i) * LDT + lkc) = rb[i];
    }
    __syncthreads();
  }
}
DI void gemm_core8(const bf16_t* __restrict__ A, int lda, const bf16_t* __restrict__ Bt, int ldb, int K,
                   f32x4 (&acc)[4][8], unsigned char* smem, int t8) {
  bf16_t* sA = (bf16_t*)smem;
  bf16_t* sB = sA + 2 * 256 * LDT;
  const int lane = t8 & 63, wave = t8 >> 6, wr = wave >> 1, wc = wave & 1, fr = lane & 15, fq = lane >> 4;
  const int lrow = t8 >> 3, lkc = (t8 & 7) * 8;
  u32x4 ra[4], rb[4];
  const int nk = K >> 6;
  const bf16_t* ga = A + (size_t)lrow * lda + lkc;
  const bf16_t* gb = Bt + (size_t)lrow * ldb + lkc;
#pragma unroll
  for (int i = 0; i < 4; ++i) { ra[i] = *(const u32x4*)(ga + (size_t)(64 * i) * lda); rb[i] = *(const u32x4*)(gb + (size_t)(64 * i) * ldb); }
#pragma unroll
  for (int i = 0; i < 4; ++i) { *(u32x4*)(sA + (lrow + 64 * i) * LDT + lkc) = ra[i]; *(u32x4*)(sB + (lrow + 64 * i) * LDT + lkc) = rb[i]; }
  __syncthreads();
  for (int kt = 0; kt < nk; ++kt) {
    const int buf = kt & 1;
    if (kt + 1 < nk) {
#pragma unroll
      for (int i = 0; i < 4; ++i) { ra[i] = *(const u32x4*)(ga + (size_t)(64 * i) * lda + (kt + 1) * 64); rb[i] = *(const u32x4*)(gb + (size_t)(64 * i) * ldb + (kt + 1) * 64); }
    }
    const bf16_t* pa = sA + buf * 256 * LDT + (wr * 64 + fr) * LDT + fq * 8;
    const bf16_t* pb = sB + buf * 256 * LDT + (wc * 128 + fr) * LDT + fq * 8;
#pragma unroll
    for (int kk = 0; kk < 2; ++kk) {
      bf16x8 af[4];
#pragma unroll
      for (int i = 0; i < 4; ++i) af[i] = *(const bf16x8*)(pa + i * 16 * LDT + kk * 32);
#pragma unroll
      for (int nh = 0; nh < 2; ++nh) {
        bf16x8 bfr[4];
#pragma unroll
        for (int i = 0; i < 4; ++i) bfr[i] = *(const bf16x8*)(pb + (nh * 4 + i) * 16 * LDT + kk * 32);
#pragma unroll
        for (int mi = 0; mi < 4; ++mi)
#pragma unroll
          for (int ni = 0; ni < 4; ++ni) acc[mi][nh * 4 + ni] = MFMA16(bfr[ni], af[mi], acc[mi][nh * 4 + ni]);
      }
    }
    if (kt + 1 < nk) {
      const int nb = buf ^ 1;
#pragma unroll
      for (int i = 0; i < 4; ++i) { *(u32x4*)(sA + nb * 256 * LDT + (lrow + 64 * i) * LDT + lkc) = ra[i]; *(u32x4*)(sB + nb * 256 * LDT + (lrow + 64 * i) * LDT + lkc) = rb[i]; }
    }
    __syncthreads();
  }
}
DI void gemm_core8b(const bf16_t* __restrict__ A, int lda, const bf16_t* __restrict__ Bt, int ldb, int K,
                    f32x4 (&acc)[4][4], unsigned char* smem, int t8) {
  bf16_t* sA = (bf16_t*)smem;
  bf16_t* sB = sA + 2 * 256 * LDT;
  const int lane = t8 & 63, wave = t8 >> 6, wr = wave >> 1, wc = wave & 1, fr = lane & 15, fq = lane >> 4;
  const int lrow = t8 >> 3, lkc = (t8 & 7) * 8;
  u32x4 ra[4], rb[2];
  const int nk = K >> 6;
  const bf16_t* ga = A + (size_t)lrow * lda + lkc;
  const bf16_t* gb = Bt + (size_t)lrow * ldb + lkc;
#pragma unroll
  for (int i = 0; i < 4; ++i) ra[i] = *(const u32x4*)(ga + (size_t)(64 * i) * lda);
#pragma unroll
  for (int i = 0; i < 2; ++i) rb[i] = *(const u32x4*)(gb + (size_t)(64 * i) * ldb);
#pragma unroll
  for (int i = 0; i < 4; ++i) *(u32x4*)(sA + (lrow + 64 * i) * LDT + lkc) = ra[i];
#pragma unroll
  for (int i = 0; i < 2; ++i) *(u32x4*)(sB + (lrow + 64 * i) * LDT + lkc) = rb[i];
  __syncthreads();
  for (int kt = 0; kt < nk; ++kt) {
    const int buf = kt & 1;
    if (kt + 1 < nk) {
#pragma unroll
      for (int i = 0; i < 4; ++i) ra[i] = *(const u32x4*)(ga + (size_t)(64 * i) * lda + (kt + 1) * 64);
#pragma unroll
      for (int i = 0; i < 2; ++i) rb[i] = *(const u32x4*)(gb + (size_t)(64 * i) * ldb + (kt + 1) * 64);
    }
    const bf16_t* pa = sA + buf * 256 * LDT + (wr * 64 + fr) * LDT + fq * 8;
    const bf16_t* pb = sB + buf * 128 * LDT + (wc * 64 + fr) * LDT + fq * 8;
#pragma unroll
    for (int kk = 0; kk < 2; ++kk) {
      bf16x8 af[4];
#pragma unroll
      for (int i = 0; i < 4; ++i) af[i] = *(const bf16x8*)(pa + i * 16 * LDT + kk * 32);
#pragma unroll
      for (int nh = 0; nh < 2; ++nh) {
        bf16x8 bfr[2];
#pragma unroll
        for (int i = 0; i < 2; ++i) bfr[i] = *(const bf16x8*)(pb + (nh * 2 + i) * 16 * LDT + kk * 32);
#pragma unroll
        for (int mi = 0; mi < 4; ++mi)
#pragma unroll
          for (int ni = 0; ni < 2; ++ni) acc[mi][nh * 2 + ni] = MFMA16(bfr[ni], af[mi], acc[mi][nh * 2 + ni]);
      }
    }
    if (kt + 1 < nk) {
      const int nb = buf ^ 1;
#pragma unroll
      for (int i = 0; i < 4; ++i) *(u32x4*)(sA + nb * 256 * LDT + (lrow + 64 * i) * LDT + lkc) = ra[i];
#pragma unroll
      for (int i = 0; i < 2; ++i) *(u32x4*)(sB + nb * 128 * LDT + (lrow + 64 * i) * LDT + lkc) = rb[i];
    }
    __syncthreads();
  }
}
DI int lds_byte8(int r, int c) { const int st = (r >> 4) * 2 + (c >> 5), rr = r & 15, cc = c & 31, ob = rr * 64 + cc * 2; return st * 1024 + (ob ^ (((ob >> 9) & 1) << 5)); }
DI void stage_rc8(int b, int& R, int& C) { const int st = b / 1024, sb = b % 1024, swz = sb ^ (((sb >> 9) & 1) << 5); R = (st >> 1) * 16 + swz / 64; C = (st & 1) * 32 + (swz % 64) / 2; }
DI void gemm8p(const bf16_t* __restrict__ A, int lda, const bf16_t* __restrict__ Bt, int ldb, int K,
               f32x4 (&acc)[2][2][4][2], unsigned char* smem, int t8) {
  const int wid = t8 >> 6, lane = t8 & 63, wr = wid >> 2, wc = wid & 3, fr = lane & 15, fq = lane >> 4;
  const int frag = (fr * 64 + fq * 16) ^ ((fr >> 3) << 5);
  const char* pA = (const char*)smem + wr * 8192 + frag;
  const char* pB = (const char*)smem + 4 * 16384 + wc * 4096 + frag;
  const int swz = ((lane * 16) ^ ((lane >> 5) << 5));
  const int R0 = (wid >> 1) * 16 + (swz >> 6), C0 = (wid & 1) * 32 + ((swz & 63) >> 1);
  unsigned offA = (unsigned)(R0 * lda + C0), offB = (unsigned)(R0 * ldb + C0);
  char* pS = (char*)smem + t8 * 16;
#define G8_STAGE_A(bh, half, kt) do { asm volatile("" : "+v"(offA)); \
    _Pragma("unroll") for (int _i = 0; _i < 2; ++_i) \
      __builtin_amdgcn_global_load_lds((const unsigned*)(A + (offA + (unsigned)(((half) * 128 + _i * 64) * lda + (kt) * 64))), \
        (unsigned*)(pS + (bh) * 16384 + _i * 8192), 16, 0, 0); } while (0)
#define G8_STAGE_B(bh, half, kt) do { asm volatile("" : "+v"(offB)); \
    _Pragma("unroll") for (int _i = 0; _i < 2; ++_i) \
      __builtin_amdgcn_global_load_lds((const unsigned*)(Bt + (offB + (unsigned)(((half) * 128 + _i * 64) * ldb + (kt) * 64))), \
        (unsigned*)(pS + (4 + (bh)) * 16384 + _i * 8192), 16, 0, 0); } while (0)
#define G8_LDA(dst, bh) _Pragma("unroll") for (int m = 0; m < 4; ++m) _Pragma("unroll") for (int k = 0; k < 2; ++k) \
    dst[m][k] = *reinterpret_cast<const bf16x8*>(pA + (bh) * 16384 + (m * 2 + k) * 1024)
#define G8_LDB(dst, bh) _Pragma("unroll") for (int n = 0; n < 2; ++n) _Pragma("unroll") for (int k = 0; k < 2; ++k) \
    dst[n][k] = *reinterpret_cast<const bf16x8*>(pB + (bh) * 16384 + (n * 2 + k) * 1024)
#define G8_MMA(ai, bj, At_, Bt_) do { __builtin_amdgcn_s_setprio(1); \
    _Pragma("unroll") for (int m = 0; m < 4; ++m) _Pragma("unroll") for (int n = 0; n < 2; ++n) _Pragma("unroll") for (int k = 0; k < 2; ++k) \
      acc[ai][bj][m][n] = MFMA16(Bt_[n][k], At_[m][k], acc[ai][bj][m][n]); \
    __builtin_amdgcn_s_setprio(0); } while (0)
#define G8_WAIT_V(n) asm volatile("s_waitcnt vmcnt(" #n ")" ::: "memory")
#define G8_WAIT_L(n) asm volatile("s_waitcnt lgkmcnt(" #n ")" ::: "memory")
#define G8_BAR __builtin_amdgcn_s_barrier()
#define G8_SCHED __builtin_amdgcn_sched_barrier(0)
  bf16x8 At[4][2], B0[2][2], B1[2][2];
  const int nt = K / 64;
  G8_WAIT_V(0);
  G8_STAGE_B(0, 0, 0); G8_STAGE_A(0, 0, 0);
  G8_STAGE_B(1, 1, 0); G8_STAGE_A(1, 1, 0);
  if (wr == 1) G8_BAR;
  G8_WAIT_V(4); G8_BAR;
  G8_STAGE_B(2, 0, 1); G8_STAGE_A(2, 0, 1); G8_STAGE_B(3, 1, 1);
  G8_WAIT_V(6); G8_BAR;
  for (int t = 0; t < nt - 2; t += 2) {
    G8_LDB(B0, 0); G8_SCHED; G8_LDA(At, 0); G8_STAGE_A(3, 1, t + 1);
    G8_WAIT_L(8); G8_BAR; G8_WAIT_L(0); G8_MMA(0, 0, At, B0); G8_BAR; G8_SCHED;
    G8_LDB(B1, 1); G8_STAGE_B(0, 0, t + 2);
    G8_BAR; G8_WAIT_L(0); G8_MMA(0, 1, At, B1); G8_BAR;
    G8_LDA(At, 1); G8_STAGE_A(0, 0, t + 2);
    G8_BAR; G8_WAIT_L(0); G8_MMA(1, 0, At, B0); G8_BAR; G8_SCHED;
    G8_STAGE_B(1, 1, t + 2);
    G8_WAIT_V(6); G8_BAR; G8_MMA(1, 1, At, B1); G8_BAR;
    G8_LDB(B0, 2); G8_SCHED; G8_LDA(At, 2); G8_STAGE_A(1, 1, t + 2);
    G8_WAIT_L(8); G8_BAR; G8_WAIT_L(0); G8_MMA(0, 0, At, B0); G8_BAR; G8_SCHED;
    G8_LDB(B1, 3); G8_STAGE_B(2, 0, t + 3);
    G8_BAR; G8_WAIT_L(0); G8_MMA(0, 1, At, B1); G8_BAR;
    G8_LDA(At, 3); G8_STAGE_A(2, 0, t + 3);
    G8_BAR; G8_WAIT_L(0); G8_MMA(1, 0, At, B0); G8_BAR; G8_SCHED;
    G8_STAGE_B(3, 1, t + 3);
    G8_WAIT_V(6); G8_BAR; G8_MMA(1, 1, At, B1); G8_BAR;
  }
  { G8_LDB(B0, 0); G8_LDA(At, 0); G8_STAGE_A(3, 1, nt - 1);
    G8_BAR; G8_WAIT_L(0); G8_MMA(0, 0, At, B0); G8_BAR;
    G8_LDB(B1, 1); G8_BAR; G8_WAIT_L(0); G8_MMA(0, 1, At, B1); G8_BAR;
    G8_LDA(At, 1); G8_WAIT_V(4); G8_BAR; G8_WAIT_L(0); G8_MMA(1, 0, At, B0); G8_MMA(1, 1, At, B1); G8_BAR; }
  { G8_LDB(B0, 2); G8_LDA(At, 2); G8_WAIT_V(2); G8_BAR; G8_WAIT_L(0); G8_MMA(0, 0, At, B0); G8_BAR;
    G8_LDB(B1, 3); G8_WAIT_V(0); G8_BAR; G8_WAIT_L(0); G8_MMA(0, 1, At, B1); G8_BAR;
    G8_LDA(At, 3); G8_BAR; G8_WAIT_L(0); G8_MMA(1, 0, At, B0); G8_MMA(1, 1, At, B1); G8_BAR; }
  if (wr == 0) G8_BAR;
}
DI void xcd_tile(int it, int WG, int NWG, int NT, int& mt, int& nt) {
  int L = it;
  if (NWG == 256) L = (it - WG) + (WG & 7) * 32 + (WG >> 3);
  const int g = L / (8 * NT), idx = L - g * (8 * NT);
  mt = g * 8 + (idx & 7); nt = idx >> 3;
}
DI void zero_acc8p(f32x4 (&acc)[2][2][4][2]) {
#pragma unroll
  for (int a = 0; a < 2; ++a)
#pragma unroll
    for (int b = 0; b < 2; ++b)
#pragma unroll
      for (int m = 0; m < 4; ++m)
#pragma unroll
        for (int n = 0; n < 2; ++n) acc[a][b][m][n] = zero4();
}
DI void zero_acc8(f32x4 (&acc)[4][8]) {
#pragma unroll
  for (int i = 0; i < 4; ++i)
#pragma unroll
    for (int j = 0; j < 8; ++j) acc[i][j] = zero4();
}
template <int NI>
DI void zero_acc(f32x4 (&acc)[4][NI]) {
#pragma unroll
  for (int i = 0; i < 4; ++i)
#pragma unroll
    for (int j = 0; j < NI; ++j) acc[i][j] = zero4();
}

DI int conv_col(int n, int mode, int base) {
  if (mode == 0) return n + base;
  if (mode == 1) return n < 1536 ? n : n + 8;
  const int g = n >> 5, s = (n >> 4) & 1, i = n & 15;
  return s * DFF + g * 16 + i;
}
DI void conv_tile(const float* __restrict__ src, int ld, bf16_t* __restrict__ dst, int Kd, int k0, int n0, int mode, int base,
                  bf16_t* tile, int tid) {
  const int n4 = (tid & 15) * 4, kr = tid >> 4;
  const int col = conv_col(n0 + n4, mode, base);
#pragma unroll
  for (int i = 0; i < 4; ++i) {
    const int k = kr + 16 * i;
    const f32x4 v = *(const f32x4*)(src + (size_t)(k0 + k) * ld + col);
    tile[(n4 + 0) * LDT + k] = f2bf(v[0]);
    tile[(n4 + 1) * LDT + k] = f2bf(v[1]);
    tile[(n4 + 2) * LDT + k] = f2bf(v[2]);
    tile[(n4 + 3) * LDT + k] = f2bf(v[3]);
  }
  __syncthreads();
  const int kc = (tid & 7) * 8, nr = tid >> 3;
#pragma unroll
  for (int i = 0; i < 2; ++i) {
    const int n = nr + 32 * i;
    *(u32x4*)(dst + (size_t)(n0 + n) * Kd + k0 + kc) = *(const u32x4*)(tile + n * LDT + kc);
  }
  __syncthreads();
}

DI void conv_item(const Params& p, int l, int it, bf16_t* tile, int tid) {
  unsigned char* ws = p.ws;
  if (it < 1024) { conv_tile(p.w_in + (size_t)l * D_ * INC, INC, (bf16_t*)(ws + O_WP), 1024, (it & 15) * 64, (it >> 4) * 64, 1, 0, tile, tid); return; }
  it -= 1024;
  if (it < 768) { conv_tile(p.w_in + (size_t)l * D_ * INC, INC, (bf16_t*)(ws + O_WG), 1024, (it & 15) * 64, (it >> 4) * 64, 0, 4104, tile, tid); return; }
  it -= 768;
  if (it < 384) { const int b = it >> 7, r = it & 127;
    conv_tile(p.w_branch + (size_t)l * 1536 * 1024 + (size_t)b * 512 * 1024, 1024, (bf16_t*)(ws + O_WBR) + (size_t)b * 1024 * 512, 512, (r & 7) * 64, (r >> 3) * 64, 0, 0, tile, tid); return; }
  it -= 384;
  if (it < 1280) { const int w = it >> 8, r = it & 255;
    const float* src = (w == 0 ? p.w_out : w == 1 ? p.xq : w == 2 ? p.xk : w == 3 ? p.xv : p.xo) + (size_t)l * 1024 * 1024;
    bf16_t* dst = (bf16_t*)(ws + (w == 0 ? O_WOUT : w == 1 ? O_WXQ : w == 2 ? O_WXK : w == 3 ? O_WXV : O_WXO));
    conv_tile(src, 1024, dst, 1024, (r & 15) * 64, (r >> 4) * 64, 0, 0, tile, tid); return; }
  it -= 1280;
  if (it < 1408) { conv_tile(p.w_gate_up + (size_t)l * 1024 * 5632, 5632, (bf16_t*)(ws + O_WGU), 1024, (it & 15) * 64, (it >> 4) * 64, 2, 0, tile, tid); return; }
  it -= 1408;
  if (it < 704) { const int kt = it % 44, nt = it / 44;
    conv_tile(p.w_down + (size_t)l * DFF * 1024, 1024, (bf16_t*)(ws + O_WD), DFF, kt * 64, nt * 64, 0, 0, tile, tid); return; }
  it -= 704;
  conv_tile(p.s5_w_glu + (size_t)l * 512 * 512, 512, (bf16_t*)(ws + O_WGLU), 512, (it & 7) * 64, (it >> 3) * 64, 0, 0, tile, tid);
}
constexpr int N_CONV = 1024 + 768 + 384 + 1280 + 1408 + 704 + 64;

DI void norm_item(const float* __restrict__ X, const float* __restrict__ gain, bf16_t* __restrict__ Hout, int row0,
                  const float* wfft, float* __restrict__ logf_out, const float* __restrict__ fbias, int tid) {
  const int lane = tid & 63, wave = tid >> 6;
  f32x4 g4[4];
#pragma unroll
  for (int i = 0; i < 4; ++i) g4[i] = *(const f32x4*)(gain + i * 256 + lane * 4);
  for (int rr = 0; rr < 8; ++rr) {
    const int row = row0 + wave * 8 + rr;
    const float* xr = X + (size_t)row * 1024;
    f32x4 v[4];
    float ss = 0.f;
#pragma unroll
    for (int i = 0; i < 4; ++i) {
      v[i] = *(const f32x4*)(xr + i * 256 + lane * 4);
      ss += v[i][0] * v[i][0] + v[i][1] * v[i][1] + v[i][2] * v[i][2] + v[i][3] * v[i][3];
    }
    ss = wave_sum(ss);
    const float rs = rsqrtf(ss * (1.f / 1024.f) + EPS);
#pragma unroll
    for (int i = 0; i < 4; ++i) {
      v[i] = v[i] * rs * g4[i];
      store_bf4(Hout + (size_t)row * 1024 + i * 256 + lane * 4, v[i]);
    }
    if (wfft) {
      float mine = 0.f;
#pragma unroll
      for (int j = 0; j < 8; ++j) {
        float a = 0.f;
#pragma unroll
        for (int i = 0; i < 4; ++i) {
          const f32x4 w = *(const f32x4*)(wfft + j * 1024 + i * 256 + lane * 4);
          a += v[i][0] * w[0] + v[i][1] * w[1] + v[i][2] * w[2] + v[i][3] * w[3];
        }
        a = wave_sum(a);
        mine = (lane == j) ? a : mine;
      }
      if (lane < 8) {
        const float xv = mine + fbias[lane];
        logf_out[(size_t)row * 8 + lane] = fminf(xv, 0.f) - __logf(1.f + __expf(-fabsf(xv)));
      }
    }
  }
}

DI void cumsum_item(const Params& p, int bh, unsigned char* smem, int tid) {
  const float* logf = (const float*)(p.ws + O_LOGF);
  float* cum = (float*)(p.ws + O_CUM);
  float* part = (float*)smem;
  const int b = bh >> 3, h = bh & 7;
  const float* src = logf + ((size_t)b * S_ + tid * 64) * 8 + h;
  float s = 0.f;
  for (int j = 0; j < 64; ++j) s += src[j * 8];
  part[tid] = s;
  __syncthreads();
  float pre = 0.f;
  for (int j = 0; j < tid; ++j) pre += part[j];
  float* dst = cum + (size_t)bh * S_ + tid * 64;
  for (int j = 0; j < 64; ++j) { pre += src[j * 8]; dst[j] = pre * LOG2E; }
  __syncthreads();
}

constexpr int LDK = 72;
DI void fox_item(const Params& p, int fox_l, int idx, unsigned char* smem, int tid) {
  bf16_t* QK = (bf16_t*)(p.ws + O_QK);
  const int bh = idx & 15, qt = 63 - (idx >> 4);
  const int b = bh >> 3, h = bh & 7;
  const int lane = tid & 63, wave = tid >> 6, fr = lane & 15, fq = lane >> 4;
  const float* cum = (const float*)(p.ws + O_CUM) + (size_t)bh * S_;
  const size_t rowbase = (size_t)b * S_;
  const int q0 = qt * 256 + wave * 32;
  bf16_t* sK = (bf16_t*)smem;
  bf16_t* sV = sK + 2 * 64 * LDK;
  float* sC = (float*)(sV + 2 * 64 * LDK);
  int* sF = (int*)(sC + 128);
  float qkb;
  {
    float gq = fabsf(p.fox_qnorm[fox_l * 64 + lane]), gk = fabsf(p.fox_knorm[fox_l * 64 + lane]);
#pragma unroll
    for (int mm = 32; mm >= 1; mm >>= 1) { gq = fmaxf(gq, __shfl_xor(gq, mm, 64)); gk = fmaxf(gk, __shfl_xor(gk, mm, 64)); }
    qkb = 8.f * LOG2E * gq * gk * 1.02f + 40.f;
  }
  bool wdone = false;
  bf16x8 qf[2][2];
  float cq[2];
#pragma unroll
  for (int f = 0; f < 2; ++f) {
    const int q = q0 + f * 16 + fr;
    const bf16_t* qp = QK + (rowbase + q) * 4096 + h * 64;
    qf[f][0] = *(const bf16x8*)(qp + fq * 8);
    qf[f][1] = *(const bf16x8*)(qp + 32 + fq * 8);
    cq[f] = cum[q];
  }
  f32x4 o[4][2];
#pragma unroll
  for (int d = 0; d < 4; ++d) { o[d][0] = zero4(); o[d][1] = zero4(); }
  float m[2] = {-1e30f, -1e30f}, ls[2] = {0.f, 0.f};
  const int ntiles = (qt + 1) * 4;
  const int kkey = tid >> 3, kdc = (tid & 7) * 8;
  const int vkey = tid & 63, vdc = (tid >> 6) * 8;
  const bf16_t* gk = QK + (rowbase + kkey) * 4096 + 512 + h * 64 + kdc;
  const bf16_t* gv = QK + (rowbase + vkey) * 4096 + 1024 + h * 64 + vdc;
  u32x4 rk0[1], rv0[1], rk1[1], rv1[1];
  float rc0 = 0.f, rc1 = 0.f;
  auto gload = [&](int t, u32x4 (&rk)[1], u32x4 (&rv)[1], float& rc) {
    const size_t off = (size_t)t * 64 * 4096;
    rk[0] = *(const u32x4*)(gk + off);
    rv[0] = *(const u32x4*)(gv + off);
    if (tid < 64) rc = cum[t * 64 + tid];
  };
  auto sstore = [&](int buf, const u32x4 (&rk)[1], const u32x4 (&rv)[1], float rc) {
    {
      *(u32x4*)(sK + buf * 64 * LDK + kkey * LDK + kdc) = rk[0];
      bf16_t* vp = sV + buf * 64 * LDK + vdc * LDK + vkey;
      const u32x4 w = rv[0];
      vp[0 * LDK] = (bf16_t)(w.x & 0xffff); vp[1 * LDK] = (bf16_t)(w.x >> 16);
      vp[2 * LDK] = (bf16_t)(w.y & 0xffff); vp[3 * LDK] = (bf16_t)(w.y >> 16);
      vp[4 * LDK] = (bf16_t)(w.z & 0xffff); vp[5 * LDK] = (bf16_t)(w.z >> 16);
      vp[6 * LDK] = (bf16_t)(w.w & 0xffff); vp[7 * LDK] = (bf16_t)(w.w >> 16);
    }
    if (tid < 64) sC[buf * 64 + tid] = rc;
  };
  auto compute = [&](int t, int buf) {
    const int k0 = t * 64;
    if (!wdone && k0 <= q0 + 31) {
      const float cnew = sC[buf * 64 + 63];
      const bool prune = (qkb + cq[0] - cnew < m[0]) && (qkb + cq[1] - cnew < m[1]);
      if (__builtin_amdgcn_ballot_w64(!prune) == 0ull) wdone = true;
    }
    if (!wdone && k0 <= q0 + 31) {
      const bf16_t* bK = sK + buf * 64 * LDK;
      const bf16_t* bV = sV + buf * 64 * LDK;
      const float* bC = sC + buf * 64;
      f32x4 s[4][2];
#pragma unroll
      for (int kf = 0; kf < 4; ++kf) {
        s[kf][0] = (f32x4){cq[0], cq[0], cq[0], cq[0]};
        s[kf][1] = (f32x4){cq[1], cq[1], cq[1], cq[1]};
      }
#pragma unroll
      for (int kk = 0; kk < 2; ++kk)
#pragma unroll
        for (int kf = 0; kf < 4; ++kf) {
          const bf16x8 a = *(const bf16x8*)(bK + (kf * 16 + fr) * LDK + kk * 32 + fq * 8);
          s[kf][0] = MFMA16(a, qf[0][kk], s[kf][0]);
          s[kf][1] = MFMA16(a, qf[1][kk], s[kf][1]);
        }
#pragma unroll
      for (int kf = 0; kf < 4; ++kf) {
        const f32x4 ck = *(const f32x4*)(bC + kf * 16 + fq * 4);
        s[kf][0] -= ck; s[kf][1] -= ck;
      }
      if (k0 + 63 > q0) {
#pragma unroll
        for (int kf = 0; kf < 4; ++kf)
#pragma unroll
          for (int f = 0; f < 2; ++f)
#pragma unroll
            for (int r = 0; r < 4; ++r) {
              const int key = k0 + kf * 16 + fq * 4 + r, q = q0 + f * 16 + fr;
              if (key > q) s[kf][f][r] = -1e30f;
            }
      }
#pragma unroll
      for (int f = 0; f < 2; ++f) {
        float mx = -1e30f;
#pragma unroll
        for (int kf = 0; kf < 4; ++kf)
#pragma unroll
          for (int r = 0; r < 4; ++r) mx = fmaxf(mx, s[kf][f][r]);
        mx = fmaxf(mx, __shfl_xor(mx, 16, 64));
        mx = fmaxf(mx, __shfl_xor(mx, 32, 64));
        const float mn = fmaxf(m[f], mx);
        const float alpha = ex2(m[f] - mn);
        m[f] = mn;
        float ps = 0.f;
#pragma unroll
        for (int kf = 0; kf < 4; ++kf)
#pragma unroll
          for (int r = 0; r < 4; ++r) { const float pv = ex2(s[kf][f][r] - mn); s[kf][f][r] = pv; ps += pv; }
        ls[f] = ls[f] * alpha + ps;
#pragma unroll
        for (int d = 0; d < 4; ++d) o[d][f] *= alpha;
      }
#pragma unroll
      for (int ss = 0; ss < 2; ++ss) {
        const bf16x8 pb0 = pack8(s[2 * ss][0], s[2 * ss + 1][0]);
        const bf16x8 pb1 = pack8(s[2 * ss][1], s[2 * ss + 1][1]);
#pragma unroll
        for (int d = 0; d < 4; ++d) {
          const bf16_t* vp = bV + (d * 16 + fr) * LDK + ss * 32 + fq * 4;
          const bf16x8 a = cat4(*(const bf16x4*)vp, *(const bf16x4*)(vp + 16));
          o[d][0] = MFMA16(a, pb0, o[d][0]);
          o[d][1] = MFMA16(a, pb1, o[d][1]);
        }
      }
    }
  };
  const int T = ntiles;
  gload(T - 1, rk0, rv0, rc0); sstore(0, rk0, rv0, rc0);
  gload(T - 2, rk0, rv0, rc0);
  if (T > 2) gload(T - 3, rk1, rv1, rc1);
  if (tid < 16) sF[tid] = 0;
  __syncthreads();
  int par = 0;
  for (int i = 0; i < T; i += 2) {
    if (i > 0) {
      int alldone = 1;
#pragma unroll
      for (int w = 0; w < 8; ++w) alldone &= sF[par * 8 + w];
      par ^= 1;
      if (alldone) break;
    }
    compute(T - 1 - i, 0);
    sstore(1, rk0, rv0, rc0);
    if (i + 3 < T) gload(T - 4 - i, rk0, rv0, rc0);
    __syncthreads();
    compute(T - 2 - i, 1);
    if (i + 2 < T) sstore(0, rk1, rv1, rc1);
    if (i + 4 < T) gload(T - 5 - i, rk1, rv1, rc1);
    if (lane == 0) sF[par * 8 + wave] = wdone ? 1 : 0;
    __syncthreads();
  }
  __syncthreads();
#pragma unroll
  for (int f = 0; f < 2; ++f) {
    float l = ls[f];
    l += __shfl_xor(l, 16, 64); l += __shfl_xor(l, 32, 64);
    const float inv = 1.f / l;
    const int q = q0 + f * 16 + fr;
    bf16_t* op = (bf16_t*)(p.ws + O_YF) + (rowbase + q) * 512 + h * 64 + fq * 4;
#pragma unroll
    for (int d = 0; d < 4; ++d) store_bf4(op + d * 16, o[d][f] * inv);
  }
}

DI float hg_lb_of(const Params& p, int l, int c) {
  float e[NL], tot = 0.f, part = 0.f;
  float mx = -1e30f;
#pragma unroll
  for (int j = 0; j < NL; ++j) { e[j] = p.hg_lb[j * 512 + c]; mx = fmaxf(mx, e[j]); }
#pragma unroll
  for (int j = 0; j < NL; ++j) { e[j] = __expf(e[j] - mx); tot += e[j]; part += (j >= 1 && j <= l) ? e[j] : 0.f; }
  return part / tot;
}
DI void hg_gate(float z, float lb, float& logf, float& key) {
  const float e = __expf(-fabsf(z));
  const float r = __builtin_amdgcn_rcpf(1.f + e);
  const float sg = (z >= 0.f ? 1.f : e) * r;
  const float sn = (z >= 0.f ? e : 1.f) * r;
  const float f = lb + (1.f - lb) * sg;
  key = (1.f - lb) * sn;
  logf = __logf(fmaxf(f, 1e-30f));
}
constexpr int LDH = 136;
DI void hg1_item(const Params& p, int l, int ch, unsigned char* smem, int tid) {
  const bf16_t* QK = (const bf16_t*)(p.ws + O_QK);
  bf16_t* SB = (bf16_t*)(p.ws + O_SBUF) + (size_t)ch * 16384;
  float* DC = (float*)(p.ws + O_DCY) + (size_t)ch * 128;
  const int bhh = ch >> 8, c = ch & 255, b = bhh >> 2, h = bhh & 3;
  const size_t row0 = (size_t)b * S_ + c * 64;
  bf16_t* kT = (bf16_t*)smem;
  bf16_t* vT = kT + 128 * LDK;
  float* sums = (float*)(vT + 128 * LDK);
  const int k = tid & 127, th = tid >> 7;
  const float lb = hg_lb_of(p, l, h * 128 + k);
  float lf[32], ky[32];
  float loc = 0.f;
  const bf16_t* zf = QK + (row0 + th * 32) * 4096 + 5 * 512 + h * 128 + k;
#pragma unroll
  for (int j = 0; j < 32; ++j) {
    hg_gate(bf2f(zf[(size_t)j * 4096]), lb, lf[j], ky[j]);
    loc += lf[j];
  }
  sums[th * 128 + k] = loc;
  {
    const int s = tid & 63, vc = (tid >> 6) * 8;
#pragma unroll
    for (int i = 0; i < 4; ++i) {
      const u32x4 w = *(const u32x4*)(QK + (row0 + s) * 4096 + 6 * 512 + h * 128 + vc + 32 * i);
      bf16_t* vp = vT + (vc + 32 * i) * LDK + s;
      vp[0 * LDK] = (bf16_t)(w.x & 0xffff); vp[1 * LDK] = (bf16_t)(w.x >> 16);
      vp[2 * LDK] = (bf16_t)(w.y & 0xffff); vp[3 * LDK] = (bf16_t)(w.y >> 16);
      vp[4 * LDK] = (bf16_t)(w.z & 0xffff); vp[5 * LDK] = (bf16_t)(w.z >> 16);
      vp[6 * LDK] = (bf16_t)(w.w & 0xffff); vp[7 * LDK] = (bf16_t)(w.w >> 16);
    }
  }
  __syncthreads();
  const float s0 = sums[k], s1 = sums[128 + k];
  const float total = s0 + s1;
  float run = th ? s0 : 0.f;
#pragma unroll
  for (int j = 0; j < 32; ++j) {
    run += lf[j];
    kT[k * LDK + th * 32 + j] = f2bf(ky[j] * __expf(total - run));
  }
  if (th == 0) DC[k] = __expf(total);
  __syncthreads();
  const int lane = tid & 63, wave = tid >> 6, fr = lane & 15, fq = lane >> 4;
  f32x4 acc[2][8];
#pragma unroll
  for (int i = 0; i < 2; ++i)
#pragma unroll
    for (int j = 0; j < 8; ++j) acc[i][j] = zero4();
#pragma unroll
  for (int ss = 0; ss < 2; ++ss) {
    bf16x8 bk[2];
#pragma unroll
    for (int i = 0; i < 2; ++i) bk[i] = *(const bf16x8*)(kT + (wave * 32 + i * 16 + fr) * LDK + ss * 32 + fq * 8);
#pragma unroll
    for (int j = 0; j < 8; ++j) {
      const bf16x8 av = *(const bf16x8*)(vT + (j * 16 + fr) * LDK + ss * 32 + fq * 8);
#pragma unroll
      for (int i = 0; i < 2; ++i) acc[i][j] = MFMA16(bk[i], av, acc[i][j]);
    }
  }
#pragma unroll
  for (int i = 0; i < 2; ++i)
#pragma unroll
    for (int j = 0; j < 8; ++j) store_bf4(SB + (j * 16 + fr) * 128 + wave * 32 + i * 16 + fq * 4, acc[i][j]);
  __syncthreads();
}
DI void hg2_item(const Params& p, int item, int tid) {
  const int gid = item * 256 + tid;
  const int bhh = gid >> 13, rem = gid & 8191, v = rem >> 6, k2 = (rem & 63) * 2;
  bf16_t* SB = (bf16_t*)(p.ws + O_SBUF) + (size_t)bhh * 256 * 16384 + v * 128 + k2;
  const float* DC = (const float*)(p.ws + O_DCY) + (size_t)bhh * 256 * 128 + k2;
  float s0 = 0.f, s1 = 0.f;
  for (int c = 0; c < 256; c += 8) {
    unsigned tmp[8]; f32x2 dc[8];
#pragma unroll
    for (int u = 0; u < 8; ++u) { tmp[u] = *(const unsigned*)(SB + (size_t)(c + u) * 16384); dc[u] = *(const f32x2*)(DC + (c + u) * 128); }
#pragma unroll
    for (int u = 0; u < 8; ++u) {
      *(unsigned*)(SB + (size_t)(c + u) * 16384) = pk2(s0, s1);
      s0 = dc[u][0] * s0 + bflo(tmp[u]);
      s1 = dc[u][1] * s1 + bfhi(tmp[u]);
    }
  }
}
DI void hg3_item(const Params& p, int l, int ch, unsigned char* smem, int tid) {
  bf16_t* QK = (bf16_t*)(p.ws + O_QK);
  const bf16_t* SB = (const bf16_t*)(p.ws + O_SBUF) + (size_t)ch * 16384;
  const int bhh = ch >> 8, c = ch & 255, b = bhh >> 2, h = bhh & 3;
  const size_t row0 = (size_t)b * S_ + c * 64;
  bf16_t* qi = (bf16_t*)smem;
  bf16_t* qa = qi + 64 * LDH;
  bf16_t* ka = qa + 64 * LDH;
  bf16_t* vT = ka + 64 * LDH;
  float* sums = (float*)(vT + 128 * LDK);
  const int k = tid & 127, th = tid >> 7;
  const float lb = hg_lb_of(p, l, h * 128 + k);
  float lf[32], ky[32];
  float loc = 0.f;
  const bf16_t* zf = QK + (row0 + th * 32) * 4096 + 5 * 512 + h * 128 + k;
  const bf16_t* zq = QK + (row0 + th * 32) * 4096 + 4 * 512 + h * 128 + k;
#pragma unroll
  for (int j = 0; j < 32; ++j) {
    hg_gate(bf2f(zf[(size_t)j * 4096]), lb, lf[j], ky[j]);
    loc += lf[j];
  }
  if (th == 0) sums[k] = loc;
  {
    const int s = tid & 63, vc = (tid >> 6) * 8;
#pragma unroll
    for (int i = 0; i < 4; ++i) {
      const u32x4 w = *(const u32x4*)(QK + (row0 + s) * 4096 + 6 * 512 + h * 128 + vc + 32 * i);
      bf16_t* vp = vT + (vc + 32 * i) * LDK + s;
      vp[0 * LDK] = (bf16_t)(w.x & 0xffff); vp[1 * LDK] = (bf16_t)(w.x >> 16);
      vp[2 * LDK] = (bf16_t)(w.y & 0xffff); vp[3 * LDK] = (bf16_t)(w.y >> 16);
      vp[4 * LDK] = (bf16_t)(w.z & 0xffff); vp[5 * LDK] = (bf16_t)(w.z >> 16);
      vp[6 * LDK] = (bf16_t)(w.w & 0xffff); vp[7 * LDK] = (bf16_t)(w.w >> 16);
    }
  }
  __syncthreads();
  {
    const float bmid = sums[k];
    float run = th ? bmid : 0.f;
#pragma unroll
    for (int j = 0; j < 32; ++j) {
      run += lf[j];
      const float qz = bf2f(zq[(size_t)j * 4096]);
      const float qs = qz * sigmoidf_(qz);
      const int t = th * 32 + j;
      const float er = __expf(run - bmid);
      qi[t * LDH + k] = f2bf(qs * __expf(run));
      qa[t * LDH + k] = f2bf(qs * er);
      ka[t * LDH + k] = f2bf(ky[j] * __expf(bmid - run));
    }
  }
  __syncthreads();
  const int lane = tid & 63, wave = tid >> 6, fr = lane & 15, fq = lane >> 4;
  const int tcol = wave * 16 + fr;
  f32x4 sc[4];
#pragma unroll
  for (int i = 0; i < 4; ++i) sc[i] = zero4();
#pragma unroll
  for (int kk = 0; kk < 4; ++kk) {
    const bf16x8 bq = *(const bf16x8*)(qa + tcol * LDH + kk * 32 + fq * 8);
#pragma unroll
    for (int sf = 0; sf < 4; ++sf) {
      const bf16x8 a = *(const bf16x8*)(ka + (sf * 16 + fr) * LDH + kk * 32 + fq * 8);
      sc[sf] = MFMA16(a, bq, sc[sf]);
    }
  }
#pragma unroll
  for (int sf = 0; sf < 4; ++sf)
#pragma unroll
    for (int r = 0; r < 4; ++r) { const int s = sf * 16 + fq * 4 + r; if (s > tcol) sc[sf][r] = 0.f; }
  f32x4 o[8];
#pragma unroll
  for (int j = 0; j < 8; ++j) o[j] = zero4();
#pragma unroll
  for (int ss = 0; ss < 2; ++ss) {
    const bf16x8 pb = pack8(sc[2 * ss], sc[2 * ss + 1]);
#pragma unroll
    for (int j = 0; j < 8; ++j) {
      const bf16_t* vp = vT + (j * 16 + fr) * LDK + ss * 32 + fq * 4;
      const bf16x8 a = cat4(*(const bf16x4*)vp, *(const bf16x4*)(vp + 16));
      o[j] = MFMA16(a, pb, o[j]);
    }
  }
#pragma unroll
  for (int kk = 0; kk < 4; ++kk) {
    const bf16x8 bq = *(const bf16x8*)(qi + tcol * LDH + kk * 32 + fq * 8);
#pragma unroll
    for (int j = 0; j < 8; ++j) {
      const bf16x8 a = *(const bf16x8*)(SB + (j * 16 + fr) * 128 + kk * 32 + fq * 8);
      o[j] = MFMA16(a, bq, o[j]);
    }
  }
  float ss = 0.f;
#pragma unroll
  for (int j = 0; j < 8; ++j) ss += o[j][0] * o[j][0] + o[j][1] * o[j][1] + o[j][2] * o[j][2] + o[j][3] * o[j][3];
  ss += __shfl_xor(ss, 16, 64); ss += __shfl_xor(ss, 32, 64);
  const float rs = rsqrtf(ss * (1.f / 128.f) + EPS);
  const float* gn = p.hg_onorm + l * 128;
  const size_t row = row0 + tcol;
#pragma unroll
  for (int j = 0; j < 8; ++j) {
    const int v = j * 16 + fq * 4;
    const f32x4 g4 = *(const f32x4*)(gn + v);
    const u32x2 gw = *(const u32x2*)(QK + row * 4096 + 7 * 512 + h * 128 + v);
    f32x4 gg = {bflo(gw.x), bfhi(gw.x), bflo(gw.y), bfhi(gw.y)};
    f32x4 y;
#pragma unroll
    for (int r = 0; r < 4; ++r) y[r] = o[j][r] * rs * g4[r] * gg[r] * sigmoidf_(gg[r]);
    store_bf4(QK + row * 4096 + 4 * 512 + h * 128 + v, y);
  }
  __syncthreads();
}

struct S5c { float abr, abi; };
DI void s5_consts(const Params& p, int l, int g, int lp, float& abr, float& abi, float& cfr, float& cfi) {
  const float dt = __expf(p.s5_log_dt[l * 32 + g]);
  const float ar = p.s5_a_re[(l * 32 + g) * 64 + lp], ai = p.s5_a_im[(l * 32 + g) * 64 + lp];
  const float mag = __expf(dt * ar);
  const float x = dt * ai;
  const float kq = rintf(x * 0.636619772367581343f);
  float r = fmaf(-kq, 1.5707855225e+00f, x);
  r = fmaf(-kq, 1.0804334124e-05f, r);
  const float r2 = r * r;
  const float sp_ = r + r * r2 * (-1.6666667163e-01f + r2 * (8.3333337680e-03f + r2 * (-1.9841270114e-04f + r2 * 2.7557314297e-06f)));
  const float cp_ = 1.f - 0.5f * r2 + r2 * r2 * (4.1666667908e-02f + r2 * (-1.3888889225e-03f + r2 * (2.4801587642e-05f + r2 * -2.7557314297e-07f)));
  const int nq = ((int)kq) & 3;
  const float sn = (nq == 0) ? sp_ : (nq == 1) ? cp_ : (nq == 2) ? -sp_ : -cp_;
  const float cs = (nq == 0) ? cp_ : (nq == 1) ? -sp_ : (nq == 2) ? -cp_ : sp_;
  abr = mag * cs; abi = mag * sn;
  const float inv = 1.f / (ar * ar + ai * ai);
  const float nr = abr - 1.f, ni = abi;
  cfr = (nr * ar + ni * ai) * inv;
  cfi = (ni * ar - nr * ai) * inv;
}
DI void s5tab_item(const Params& p, int l, int item, int tid) {
  const int gid = item * 256 + tid;
  const int g = gid >> 6, lp = gid & 63;
  float abr, abi, cfr, cfi;
  s5_consts(p, l, g, lp, abr, abi, cfr, cfi);
  float* tb = (float*)(p.ws + O_S5T) + (size_t)gid * 36;
  const float* br = p.s5_b_re + ((size_t)(l * 32 + g) * 64 + lp) * 16;
  const float* bi = p.s5_b_im + ((size_t)(l * 32 + g) * 64 + lp) * 16;
  *(f32x4*)tb = (f32x4){abr, abi, 0.f, 0.f};
#pragma unroll
  for (int q = 0; q < 4; ++q) {
    const f32x4 r4 = *(const f32x4*)(br + q * 4), i4 = *(const f32x4*)(bi + q * 4);
    *(f32x4*)(tb + 4 + q * 4) = cfr * r4 - cfi * i4;
    *(f32x4*)(tb + 20 + q * 4) = cfr * i4 + cfi * r4;
  }
}
DI void s5_load(const Params& p, int g, int lane, float& abr, float& abi, float (&bbr)[16], float (&bbi)[16]) {
  const float* tb = (const float*)(p.ws + O_S5T) + (size_t)(g * 64 + lane) * 36;
  const f32x4 a = *(const f32x4*)tb;
  abr = a[0]; abi = a[1];
#pragma unroll
  for (int q = 0; q < 4; ++q) {
    const f32x4 r4 = *(const f32x4*)(tb + 4 + q * 4), i4 = *(const f32x4*)(tb + 20 + q * 4);
#pragma unroll
    for (int e = 0; e < 4; ++e) { bbr[q * 4 + e] = r4[e]; bbi[q * 4 + e] = i4[e]; }
  }
}
DI void s5a_item(const Params& p, int l, int item, unsigned char* smem, int tid) {
  const bf16_t* QK = (const bf16_t*)(p.ws + O_QK);
  f32x2* E = (f32x2*)(p.ws + O_S5E);
  const int lane = tid & 63, wave = tid >> 6;
  const int wi = item * 4 + wave;
  const int g = wi & 31, c = (wi >> 5) & 127, b = wi >> 12;
  float* us = (float*)smem + wave * 2048;
  float abr, abi;
  float bbr[16], bbi[16];
  s5_load(p, g, lane, abr, abi, bbr, bbi);
  const size_t row0 = (size_t)b * S_ + c * 128;
#pragma unroll
  for (int i = 0; i < 2; ++i) {
    const int t = lane + 64 * i;
    const bf16_t* up = QK + (row0 + t) * 4096 + 3 * 512 + g * 16;
    const u32x4 w0 = *(const u32x4*)up, w1 = *(const u32x4*)(up + 8);
    float* d = us + t * 16;
    *(f32x4*)(d + 0) = (f32x4){bflo(w0.x), bfhi(w0.x), bflo(w0.y), bfhi(w0.y)};
    *(f32x4*)(d + 4) = (f32x4){bflo(w0.z), bfhi(w0.z), bflo(w0.w), bfhi(w0.w)};
    *(f32x4*)(d + 8) = (f32x4){bflo(w1.x), bfhi(w1.x), bflo(w1.y), bfhi(w1.y)};
    *(f32x4*)(d + 12) = (f32x4){bflo(w1.z), bfhi(w1.z), bflo(w1.w), bfhi(w1.w)};
  }
  __syncthreads();
  float hr = 0.f, hi = 0.f;
  for (int t = 0; t < 128; ++t) {
    const float* u = us + t * 16;
    float dr = 0.f, di = 0.f;
#pragma unroll
    for (int q = 0; q < 4; ++q) {
      const f32x4 u4 = *(const f32x4*)(u + q * 4);
#pragma unroll
      for (int e = 0; e < 4; ++e) { dr += bbr[q * 4 + e] * u4[e]; di += bbi[q * 4 + e] * u4[e]; }
    }
    const float nr = abr * hr - abi * hi + dr;
    const float ni = abr * hi + abi * hr + di;
    hr = nr; hi = ni;
  }
  E[((size_t)(b * 32 + g) * 128 + c) * 64 + lane] = (f32x2){hr, hi};
  __syncthreads();
}
DI void s5b_item(const Params& p, int l, int item, int tid) {
  const int gid = item * 256 + tid;
  const int bg = gid >> 6, lp = gid & 63, g = bg & 31;
  const f32x4 ab4 = *(const f32x4*)((const float*)(p.ws + O_S5T) + (size_t)(g * 64 + lp) * 36);
  const float abr = ab4[0], abi = ab4[1];
  float pr = abr, pi = abi;
#pragma unroll
  for (int i = 0; i < 7; ++i) { const float nr = pr * pr - pi * pi, ni = 2.f * pr * pi; pr = nr; pi = ni; }
  f32x2* E = (f32x2*)(p.ws + O_S5E) + (size_t)bg * 128 * 64 + lp;
  float hr = 0.f, hi = 0.f;
  for (int c = 0; c < 128; c += 8) {
    f32x2 e[8];
#pragma unroll
    for (int u = 0; u < 8; ++u) e[u] = E[(size_t)(c + u) * 64];
#pragma unroll
    for (int u = 0; u < 8; ++u) {
      E[(size_t)(c + u) * 64] = (f32x2){hr, hi};
      const float nr = pr * hr - pi * hi + e[u][0];
      const float ni = pr * hi + pi * hr + e[u][1];
      hr = nr; hi = ni;
    }
  }
}
DI float gelu_tanh(float y) {
  const float u = 1.5957691216057308f * (y + 0.044715f * y * y * y);
  return y * __builtin_amdgcn_rcpf(1.f + __expf(-u));
}
DI void s5c_item(const Params& p, int l, int item, unsigned char* smem, int tid) {
  bf16_t* QK = (bf16_t*)(p.ws + O_QK);
  const f32x2* E = (const f32x2*)(p.ws + O_S5E);
  const int lane = tid & 63, wave = tid >> 6, fr = lane & 15, fq = lane >> 4;
  const int wi = item * 4 + wave;
  const int g = wi & 31, c = (wi >> 5) & 127, b = wi >> 12;
  float* us = (float*)smem + wave * 2048;
  bf16_t* Hs = (bf16_t*)(smem + 32768) + wave * 16 * LDH;
  float abr, abi;
  float bbr[16], bbi[16];
  s5_load(p, g, lane, abr, abi, bbr, bbi);
  bf16x8 cop[4];
#pragma unroll
  for (int kk = 0; kk < 4; ++kk) {
    const int k = kk * 32 + fq * 8;
    const float* src = (k < 64 ? p.s5_c_re : p.s5_c_im) + ((size_t)(l * 32 + g) * 16 + fr) * 64 + (k & 63);
    const float sg = k < 64 ? 1.f : -1.f;
    const f32x4 a = *(const f32x4*)src * sg, bq = *(const f32x4*)(src + 4) * sg;
    cop[kk] = pack8(a, bq);
  }
  const f32x4 dsk = *(const f32x4*)(p.s5_d + l * 512 + g * 16 + fq * 4);
  const size_t row0 = (size_t)b * S_ + c * 128;
#pragma unroll
  for (int i = 0; i < 2; ++i) {
    const int t = lane + 64 * i;
    const bf16_t* up = QK + (row0 + t) * 4096 + 3 * 512 + g * 16;
    const u32x4 w0 = *(const u32x4*)up, w1 = *(const u32x4*)(up + 8);
    float* d = us + t * 16;
    *(f32x4*)(d + 0) = (f32x4){bflo(w0.x), bfhi(w0.x), bflo(w0.y), bfhi(w0.y)};
    *(f32x4*)(d + 4) = (f32x4){bflo(w0.z), bfhi(w0.z), bflo(w0.w), bfhi(w0.w)};
    *(f32x4*)(d + 8) = (f32x4){bflo(w1.x), bfhi(w1.x), bflo(w1.y), bfhi(w1.y)};
    *(f32x4*)(d + 12) = (f32x4){bflo(w1.z), bfhi(w1.z), bflo(w1.w), bfhi(w1.w)};
  }
  const f32x2 e0 = E[((size_t)(b * 32 + g) * 128 + c) * 64 + lane];
  float hr = e0[0], hi = e0[1];
  __syncthreads();
  for (int tb = 0; tb < 8; ++tb) {
    for (int tt = 0; tt < 16; ++tt) {
      const float* u = us + (tb * 16 + tt) * 16;
      float dr = 0.f, di = 0.f;
#pragma unroll
      for (int q = 0; q < 4; ++q) {
        const f32x4 u4 = *(const f32x4*)(u + q * 4);
#pragma unroll
        for (int e = 0; e < 4; ++e) { dr += bbr[q * 4 + e] * u4[e]; di += bbi[q * 4 + e] * u4[e]; }
      }
      const float nr = abr * hr - abi * hi + dr;
      const float ni = abr * hi + abi * hr + di;
      hr = nr; hi = ni;
      Hs[tt * LDH + lane] = f2bf(hr);
      Hs[tt * LDH + 64 + lane] = f2bf(hi);
    }
    __syncthreads();
    f32x4 y = zero4();
#pragma unroll
    for (int kk = 0; kk < 4; ++kk) {
      const bf16x8 hb = *(const bf16x8*)(Hs + fr * LDH + kk * 32 + fq * 8);
      y = MFMA16(cop[kk], hb, y);
    }
    const int t = tb * 16 + fr;
    const f32x4 u4 = *(const f32x4*)(us + t * 16 + fq * 4);
    f32x4 z;
#pragma unroll
    for (int r = 0; r < 4; ++r) z[r] = gelu_tanh(y[r] + dsk[r] * u4[r]);
    store_bf4(QK + (row0 + t) * 4096 + 3 * 512 + g * 16 + fq * 4, z);
    __syncthreads();
  }
}

DI void kxnorm_item(const Params& p, int l, int item, int tid) {
  const int lane = tid & 63, wave = tid >> 6;
  const int wi = item * 4 + wave;
  const int row = wi >> 2, hd = wi & 3;
  const float* src = (const float*)(p.ws + O_KXR) + (size_t)row * 1024 + hd * 256 + lane * 4;
  const f32x4 v = *(const f32x4*)src;
  float ss = v[0] * v[0] + v[1] * v[1] + v[2] * v[2] + v[3] * v[3];
  ss = wave_sum(ss);
  const float rs = rsqrtf(ss * (1.f / 256.f) + EPS);
  const f32x4 g4 = *(const f32x4*)(p.x_knorm + l * 256 + lane * 4);
  store_bf4((bf16_t*)(p.ws + O_KXN) + (size_t)row * 1024 + hd * 256 + lane * 4, v * rs * g4);
}
constexpr int LDX = 264;
DI void xattn_item(const Params& p, int l, int item, unsigned char* smem, int tid) {
  const bf16_t* QX = (const bf16_t*)(p.ws + O_QK);
  bf16_t* OX = (bf16_t*)(p.ws + O_QK) + (size_t)T_ * 1024;
  const bf16_t* KXN = (const bf16_t*)(p.ws + O_KXN);
  const bf16_t* VXT = (const bf16_t*)(p.ws + O_VXT);
  const int lane = tid & 63, wave = tid >> 6, fr = lane & 15, fq = lane >> 4;
  const int hd = item & 3, rt = item >> 2;
  const int b = rt >> 7;
  const size_t row = (size_t)rt * 128 + wave * 16 + fr;
  bf16_t* sT = (bf16_t*)smem;
  bf16x8 qf[8];
  {
    float ss = 0.f;
    f32x4 qa[8][2];
    const bf16_t* qp = QX + row * 1024 + hd * 256 + fq * 8;
#pragma unroll
    for (int kk = 0; kk < 8; ++kk) {
      const u32x4 w = *(const u32x4*)(qp + kk * 32);
      qa[kk][0] = (f32x4){bflo(w.x), bfhi(w.x), bflo(w.y), bfhi(w.y)};
      qa[kk][1] = (f32x4){bflo(w.z), bfhi(w.z), bflo(w.w), bfhi(w.w)};
#pragma unroll
      for (int e = 0; e < 4; ++e) ss += qa[kk][0][e] * qa[kk][0][e] + qa[kk][1][e] * qa[kk][1][e];
    }
    ss += __shfl_xor(ss, 16, 64); ss += __shfl_xor(ss, 32, 64);
    const float rs = rsqrtf(ss * (1.f / 256.f) + EPS) * (0.0625f * LOG2E);
    const float* gq = p.x_qnorm + l * 256 + fq * 8;
#pragma unroll
    for (int kk = 0; kk < 8; ++kk) {
      const f32x4 g0 = *(const f32x4*)(gq + kk * 32), g1 = *(const f32x4*)(gq + kk * 32 + 4);
      qf[kk] = pack8(qa[kk][0] * rs * g0, qa[kk][1] * rs * g1);
    }
  }
  f32x4 s[16];
#pragma unroll
  for (int i = 0; i < 16; ++i) s[i] = zero4();
#pragma unroll
  for (int jt = 0; jt < 4; ++jt) {
#pragma unroll
    for (int i = 0; i < 4; ++i) {
      const int cidx = tid + 512 * i, key = cidx >> 5, dc = (cidx & 31) * 8;
      *(u32x4*)(sT + key * LDX + dc) = *(const u32x4*)(KXN + ((size_t)b * 256 + jt * 64 + key) * 1024 + hd * 256 + dc);
    }
    __syncthreads();
#pragma unroll
    for (int kk = 0; kk < 8; ++kk)
#pragma unroll
      for (int mf = 0; mf < 4; ++mf) {
        const bf16x8 a = *(const bf16x8*)(sT + (mf * 16 + fr) * LDX + kk * 32 + fq * 8);
        s[jt * 4 + mf] = MFMA16(a, qf[kk], s[jt * 4 + mf]);
      }
    __syncthreads();
  }
  float mx = -1e30f;
#pragma unroll
  for (int i = 0; i < 16; ++i)
#pragma unroll
    for (int r = 0; r < 4; ++r) mx = fmaxf(mx, s[i][r]);
  mx = fmaxf(mx, __shfl_xor(mx, 16, 64)); mx = fmaxf(mx, __shfl_xor(mx, 32, 64));
  float ls = 0.f;
#pragma unroll
  for (int i = 0; i < 16; ++i)
#pragma unroll
    for (int r = 0; r < 4; ++r) { const float pv = ex2(s[i][r] - mx); s[i][r] = pv; ls += pv; }
  ls += __shfl_xor(ls, 16, 64); ls += __shfl_xor(ls, 32, 64);
  const float inv = 1.f / ls;
  bf16x8 pp[8];
#pragma unroll
  for (int i = 0; i < 8; ++i) pp[i] = pack8(s[2 * i], s[2 * i + 1]);
  f32x4 o[16];
#pragma unroll
  for (int i = 0; i < 16; ++i) o[i] = zero4();
#pragma unroll
  for (int jt = 0; jt < 4; ++jt) {
#pragma unroll
    for (int i = 0; i < 4; ++i) {
      const int cidx = tid + 512 * i, d = cidx >> 3, mc = (cidx & 7) * 8;
      *(u32x4*)(sT + d * LDK + mc) = *(const u32x4*)(VXT + ((size_t)b * 1024 + hd * 256 + d) * 256 + jt * 64 + mc);
    }
    __syncthreads();
#pragma unroll
    for (int ss = 0; ss < 2; ++ss) {
      const bf16x8 pb = pp[jt * 2 + ss];
#pragma unroll
      for (int df = 0; df < 16; ++df) {
        const bf16_t* vp = sT + (df * 16 + fr) * LDK + ss * 32 + fq * 4;
        const bf16x8 a = cat4(*(const bf16x4*)vp, *(const bf16x4*)(vp + 16));
        o[df] = MFMA16(a, pb, o[df]);
      }
    }
    __syncthreads();
  }
  bf16_t* op = OX + row * 1024 + hd * 256 + fq * 4;
#pragma unroll
  for (int df = 0; df < 16; ++df) store_bf4(op + df * 16, o[df] * inv);
}

__global__ void __launch_bounds__(512, 2) mega(Params p, int ph_lo, int ph_hi, int coop) {
  __shared__ __attribute__((aligned(16))) unsigned char smem_all[147456];
#ifdef DIAG_ZERO
  if (ph_lo == 0) {
    u32x4* w4 = (u32x4*)p.ws;
    const u32x4 z4 = {0u, 0u, 0u, 0u};
    for (size_t i = (size_t)blockIdx.x * 256 + threadIdx.x; i < O_END / 16; i += (size_t)gridDim.x * 256) w4[i] = z4;
    u32x4* o4 = (u32x4*)p.out;
    for (size_t i = (size_t)blockIdx.x * 256 + threadIdx.x; i < (size_t)T_ * 1024 / 4; i += (size_t)gridDim.x * 256) o4[i] = z4;
    for (int i = threadIdx.x; i < 73728 / 16; i += 256) ((u32x4*)smem)[i] = z4;
    __syncthreads();
    if (coop) cg::this_grid().sync();
  }
#endif
  if (coop) {
    if (blockIdx.x == 0 && threadIdx.x == 0) __hip_atomic_store((unsigned*)(p.ws + O_BAR), 0u, __ATOMIC_RELAXED, __HIP_MEMORY_SCOPE_AGENT);
    cg::this_grid().sync();
  }
  for (int ph = ph_lo; ph < ph_hi; ++ph) {
#ifdef REP_MASK
    const int nrep = ((REP_MASK >> (ph % NPH)) & 1) ? 2 : 1;
#else
    const int nrep = 1;
#endif
    for (int rep = 0; rep < nrep; ++rep) {
    int tid = threadIdx.x, G = gridDim.x * 2, bid = blockIdx.x * 2;
    asm volatile("" : "+v"(tid));
    asm volatile("" : "+s"(G));
    const int sub = __builtin_amdgcn_readfirstlane(tid >> 8);
    tid &= 255;
    bid += sub;
    unsigned char* smem = smem_all + sub * 73728;
    int t8 = threadIdx.x, WG = blockIdx.x, NWG = gridDim.x;
    asm volatile("" : "+v"(t8));
    asm volatile("" : "+s"(WG));
    asm volatile("" : "+s"(NWG));
    const int wr8 = t8 >> 7, wc8 = (t8 >> 6) & 1;
    const int wr2 = t8 >> 8, wc4 = (t8 >> 6) & 3;
    const int lane = tid & 63, wave = tid >> 6, wr = wave >> 1, wc = wave & 1, fr = lane & 15, fq = lane >> 4;
    unsigned char* ws = p.ws;
    asm volatile("" : "+s"(ws));
    bf16_t* HB = (bf16_t*)(ws + O_HB);
    bf16_t* QK = (bf16_t*)(ws + O_QK);
    const int l = ph / NPH;
#ifdef ONLY_SP
    const int sp = ONLY_SP;
#else
    const int sp = ph % NPH;
#endif
    const float* xin = (l == 0) ? p.x : p.out;
    if (sp == 0) {
      float* wfft = (float*)smem;
      bf16_t* ctile = (bf16_t*)(smem + 32768);
      {
        const float* wsrc = p.w_in + (size_t)l * D_ * INC + 1536;
        for (int i = tid; i < 2048; i += 256) {
          const int k = i >> 1, j4 = (i & 1) * 4;
          const f32x4 v = *(const f32x4*)(wsrc + (size_t)k * INC + j4);
          wfft[(j4 + 0) * 1024 + k] = v[0]; wfft[(j4 + 1) * 1024 + k] = v[1];
          wfft[(j4 + 2) * 1024 + k] = v[2]; wfft[(j4 + 3) * 1024 + k] = v[3];
        }
        __syncthreads();
      }
      const int total = 1024 + 16 + N_CONV + 8;
      for (int it = bid; it < total; it += G) {
        if (it < 1024) norm_item(xin, p.norm_mix + l * 1024, HB, it * 32, wfft, (float*)(ws + O_LOGF), p.fox_fbias + l * 8, tid);
        else if (it < 1040) norm_item(p.mem, p.norm_mem + l * 1024, (bf16_t*)(ws + O_MEMN), (it - 1024) * 32, nullptr, nullptr, nullptr, tid);
        else if (it < 1040 + N_CONV) conv_item(p, l, it - 1040, ctile, tid);
        else s5tab_item(p, l, it - 1040 - N_CONV, tid);
      }
    } else if (sp == 1) {
      for (int it = bid; it < 16 + 64; it += G) {
        if (it < 16) { cumsum_item(p, it, smem, tid); continue; }
        f32x4 acc[4][4];
        zero_acc<4>(acc);
        const int t = it - 16, nt = t & 15, mt = t >> 4;
        const int m0 = mt * 128, n0 = (nt & 7) * 128;
        const bf16_t* W = (const bf16_t*)(ws + (nt < 8 ? O_WXK : O_WXV));
        gemm_core<4>((const bf16_t*)(ws + O_MEMN) + (size_t)m0 * 1024, 1024, W + (size_t)n0 * 1024, 1024, 1024, acc, smem, tid);
        if (nt < 8) {
          float* KXR = (float*)(ws + O_KXR);
#pragma unroll
          for (int mi = 0; mi < 4; ++mi) {
            const size_t row = m0 + wr * 64 + mi * 16 + fr;
#pragma unroll
            for (int ni = 0; ni < 4; ++ni) *(f32x4*)(KXR + row * 1024 + n0 + wc * 64 + ni * 16 + fq * 4) = acc[mi][ni];
          }
        } else {
          bf16_t* VXT = (bf16_t*)(ws + O_VXT);
#pragma unroll
          for (int mi = 0; mi < 4; ++mi) {
            const int row = m0 + wr * 64 + mi * 16 + fr, bb = row >> 8, mm = row & 255;
#pragma unroll
            for (int ni = 0; ni < 4; ++ni)
#pragma unroll
              for (int r = 0; r < 4; ++r) VXT[((size_t)bb * 1024 + n0 + wc * 64 + ni * 16 + fq * 4 + r) * 256 + mm] = f2bf(acc[mi][ni][r]);
          }
        }
      }
      for (int it = WG; it < 2048; it += NWG) {
        int nt, mt; xcd_tile(it, WG, NWG, 16, mt, nt);
        const int m0 = mt * 256, n0 = nt * 256;
        f32x4 acc[2][2][4][2];
        zero_acc8p(acc);
        gemm8p(HB + (size_t)m0 * 1024, 1024, (const bf16_t*)(ws + O_WP) + (size_t)n0 * 1024, 1024, 1024, acc, smem_all, t8);
        const int slot = n0 >> 9;
        if (slot < 2) {
          const float* gn = (slot == 0 ? p.fox_qnorm : p.fox_knorm) + l * 64 + (wc4 & 1) * 32 + fq * 4;
          const float scl = slot == 0 ? 0.125f * LOG2E : 1.f;
          float* xs = (float*)smem_all;
          const int wid8 = t8 >> 6;
          float part[2][2][4];
#pragma unroll
          for (int ai = 0; ai < 2; ++ai)
#pragma unroll
            for (int bj = 0; bj < 2; ++bj)
#pragma unroll
              for (int m = 0; m < 4; ++m) {
                float ss = 0.f;
#pragma unroll
                for (int n = 0; n < 2; ++n)
#pragma unroll
                  for (int r = 0; r < 4; ++r) ss += acc[ai][bj][m][n][r] * acc[ai][bj][m][n][r];
                ss += __shfl_xor(ss, 16, 64); ss += __shfl_xor(ss, 32, 64);
                part[ai][bj][m] = ss;
                if (fq == 0) xs[(wid8 * 16 + (ai * 2 + bj) * 4 + m) * 16 + fr] = ss;
              }
          __syncthreads();
          const f32x4 g0 = *(const f32x4*)gn, g1 = *(const f32x4*)(gn + 16);
#pragma unroll
          for (int ai = 0; ai < 2; ++ai)
#pragma unroll
            for (int m = 0; m < 4; ++m) {
              const size_t row = m0 + ai * 128 + wr2 * 64 + m * 16 + fr;
#pragma unroll
              for (int bj = 0; bj < 2; ++bj) {
                const float tot = part[ai][bj][m] + xs[((wid8 ^ 1) * 16 + (ai * 2 + bj) * 4 + m) * 16 + fr];
                const float rs = rsqrtf(tot * (1.f / 64.f) + EPS) * scl;
                bf16_t* dst = QK + row * 4096 + n0 + bj * 128 + wc4 * 32 + fq * 4;
                store_bf4(dst, acc[ai][bj][m][0] * rs * g0);
                store_bf4(dst + 16, acc[ai][bj][m][1] * rs * g1);
              }
            }
          __syncthreads();
        } else {
#pragma unroll
          for (int ai = 0; ai < 2; ++ai)
#pragma unroll
            for (int m = 0; m < 4; ++m) {
              const size_t row = m0 + ai * 128 + wr2 * 64 + m * 16 + fr;
#pragma unroll
              for (int bj = 0; bj < 2; ++bj)
#pragma unroll
                for (int n = 0; n < 2; ++n) store_bf4(QK + row * 4096 + n0 + bj * 128 + wc4 * 32 + n * 16 + fq * 4, acc[ai][bj][m][n]);
            }
        }
      }
    } else if (sp == 2) {
      const int total = 2048 + 2048 + 512;
      for (int it = bid; it < total; it += G) {
        if (it < 2048) hg1_item(p, l, it, smem, tid);
        else if (it < 4096) s5a_item(p, l, it - 2048, smem, tid);
        else kxnorm_item(p, l, it - 4096, tid);
      }
    } else if (sp == 3) {
      const int total = 256 + 16;
      for (int it = bid; it < total; it += G) {
        if (it < 256) hg2_item(p, it, tid);
        else s5b_item(p, l, it - 256, tid);
      }
    } else if (sp == 4) {
      for (int it = WG; it < 1024; it += NWG) {
        int idx = it;
        const int j = it / NWG;
        if ((j & 1) && (j + 1) * NWG <= 1024) idx = j * NWG + (NWG - 1 - (it - j * NWG));
        fox_item(p, l, idx, smem_all, t8);
      }
      for (int it = bid; it < 4096; it += G) {
        if (it < 2048) hg3_item(p, l, it, smem, tid);
        else s5c_item(p, l, it - 2048, smem, tid);
      }
    } else if (sp == 5) {
      const float* bg = p.s5_b_glu + l * 512;
      for (int it = WG; it < 256; it += NWG) {
        int nt, mt; xcd_tile(it, WG, NWG, 2, mt, nt);
        const int m0 = mt * 256, n0 = nt * 256;
        f32x4 acc[2][2][4][2];
        zero_acc8p(acc);
        gemm8p(QK + (size_t)m0 * 4096 + 3 * 512, 4096, (const bf16_t*)(ws + O_WGLU) + (size_t)n0 * 512, 512, 512, acc, smem_all, t8);
#pragma unroll
        for (int ai = 0; ai < 2; ++ai)
#pragma unroll
          for (int m = 0; m < 4; ++m) {
            const size_t row = m0 + ai * 128 + wr2 * 64 + m * 16 + fr;
#pragma unroll
            for (int bj = 0; bj < 2; ++bj)
#pragma unroll
              for (int n = 0; n < 2; ++n) {
                const int col = n0 + bj * 128 + wc4 * 32 + n * 16 + fq * 4;
                const f32x4 b4 = *(const f32x4*)(bg + col);
                const u32x2 zw = *(const u32x2*)(QK + row * 4096 + 3 * 512 + col);
                const f32x4 z = {bflo(zw.x), bfhi(zw.x), bflo(zw.y), bfhi(zw.y)};
                f32x4 y;
#pragma unroll
                for (int r = 0; r < 4; ++r) y[r] = z[r] * sigmoidf_(acc[ai][bj][m][n][r] + b4[r]);
                store_bf4(QK + row * 4096 + 5 * 512 + col, y);
              }
          }
      }
    } else if (sp == 6) {
      for (int it = WG; it < 512; it += NWG) {
        int nt, mt; xcd_tile(it, WG, NWG, 4, mt, nt);
        const int m0 = mt * 256, n0 = nt * 256;
#pragma unroll 1
        for (int br = 0; br < 3; ++br) {
          f32x4 acc[2][2][4][2];
          zero_acc8p(acc);
          gemm8p(HB + (size_t)m0 * 1024, 1024, (const bf16_t*)(ws + O_WG) + (size_t)(br * 1024 + n0) * 1024, 1024, 1024, acc, smem_all, t8);
          { int tq = threadIdx.x; asm volatile("" : "+v"(tq));
          u32x4* gs = (u32x4*)(ws + O_GS) + ((size_t)WG * 512 + tq) * 16;
#pragma unroll
          for (int ai = 0; ai < 2; ++ai)
#pragma unroll
            for (int bj = 0; bj < 2; ++bj)
#pragma unroll
              for (int m = 0; m < 4; ++m) {
                u32x4 g;
                g.x = pk2(sigmoidf_(acc[ai][bj][m][0][0]), sigmoidf_(acc[ai][bj][m][0][1]));
                g.y = pk2(sigmoidf_(acc[ai][bj][m][0][2]), sigmoidf_(acc[ai][bj][m][0][3]));
                g.z = pk2(sigmoidf_(acc[ai][bj][m][1][0]), sigmoidf_(acc[ai][bj][m][1][1]));
                g.w = pk2(sigmoidf_(acc[ai][bj][m][1][2]), sigmoidf_(acc[ai][bj][m][1][3]));
                gs[(ai * 2 + bj) * 4 + m] = g;
              }
          }
          zero_acc8p(acc);
          const bf16_t* Ab = br == 0 ? (const bf16_t*)(ws + O_YF) + (size_t)m0 * 512 : QK + (size_t)m0 * 4096 + (br == 1 ? 5 : 4) * 512;
          gemm8p(Ab, br == 0 ? 512 : 4096, (const bf16_t*)(ws + O_WBR) + (size_t)br * 1024 * 512 + (size_t)n0 * 512, 512, 512, acc, smem_all, t8);
          int tq2 = threadIdx.x; asm volatile("" : "+v"(tq2));
          const u32x4* gs = (const u32x4*)(ws + O_GS) + ((size_t)WG * 512 + tq2) * 16;
          const int fr_e = tq2 & 15, fq_e = (tq2 >> 4) & 3, wr_e = tq2 >> 8, wc_e = (tq2 >> 6) & 3;
#pragma unroll
          for (int ai = 0; ai < 2; ++ai)
#pragma unroll
            for (int m = 0; m < 4; ++m) {
              const size_t row = m0 + ai * 128 + wr_e * 64 + m * 16 + fr_e;
#pragma unroll
              for (int bj = 0; bj < 2; ++bj) {
                const u32x4 g = gs[(ai * 2 + bj) * 4 + m];
                bf16_t* dst = QK + row * 4096 + 512 + n0 + bj * 128 + wc_e * 32 + fq_e * 4;
                f32x4 v0 = acc[ai][bj][m][0] * (f32x4){bflo(g.x), bfhi(g.x), bflo(g.y), bfhi(g.y)};
                f32x4 v1 = acc[ai][bj][m][1] * (f32x4){bflo(g.z), bfhi(g.z), bflo(g.w), bfhi(g.w)};
                if (br > 0) {
                  const u32x2 o0 = *(const u32x2*)dst, o1 = *(const u32x2*)(dst + 16);
                  v0 += (f32x4){bflo(o0.x), bfhi(o0.x), bflo(o0.y), bfhi(o0.y)};
                  v1 += (f32x4){bflo(o1.x), bfhi(o1.x), bflo(o1.y), bfhi(o1.y)};
                }
                store_bf4(dst, v0);
                store_bf4(dst + 16, v1);
              }
            }
        }
      }
    } else if (sp == 7 || sp == 11 || sp == 14) {
      const bf16_t* A; int lda, K; const bf16_t* W;
      const float* rin;
      if (sp == 7) { A = QK + 512; lda = 4096; K = 1024; W = (const bf16_t*)(ws + O_WOUT); rin = xin; }
      else if (sp == 11) { A = QK + (size_t)T_ * 1024; lda = 1024; K = 1024; W = (const bf16_t*)(ws + O_WXO); rin = p.out; }
      else { A = QK; lda = DFF; K = DFF; W = (const bf16_t*)(ws + O_WD); rin = p.out; }
      for (int it = WG; it < 512; it += NWG) {
        int nt, mt; xcd_tile(it, WG, NWG, 4, mt, nt);
        const int m0 = mt * 256, n0 = nt * 256;
        f32x4 acc[2][2][4][2];
        zero_acc8p(acc);
        gemm8p(A + (size_t)m0 * lda, lda, W + (size_t)n0 * K, K, K, acc, smem_all, t8);
#pragma unroll
        for (int ai = 0; ai < 2; ++ai)
#pragma unroll
          for (int m = 0; m < 4; ++m) {
            const size_t row = m0 + ai * 128 + wr2 * 64 + m * 16 + fr;
#pragma unroll
            for (int bj = 0; bj < 2; ++bj)
#pragma unroll
              for (int n = 0; n < 2; ++n) {
                const size_t o = row * 1024 + n0 + bj * 128 + wc4 * 32 + n * 16 + fq * 4;
                *(f32x4*)(p.out + o) = *(const f32x4*)(rin + o) + acc[ai][bj][m][n];
              }
          }
      }
    } else if (sp == 8 || sp == 12) {
      const float* gn = (sp == 8 ? p.norm_x : p.norm_ffn) + l * 1024;
      for (int it = bid; it < 1024; it += G) norm_item(p.out, gn, HB, it * 32, nullptr, nullptr, nullptr, tid);
    } else if (sp == 9) {
      for (int it = WG; it < 512; it += NWG) {
        int nt, mt; xcd_tile(it, WG, NWG, 4, mt, nt);
        const int m0 = mt * 256, n0 = nt * 256;
        f32x4 acc[2][2][4][2];
        zero_acc8p(acc);
        gemm8p(HB + (size_t)m0 * 1024, 1024, (const bf16_t*)(ws + O_WXQ) + (size_t)n0 * 1024, 1024, 1024, acc, smem_all, t8);
#pragma unroll
        for (int ai = 0; ai < 2; ++ai)
#pragma unroll
          for (int m = 0; m < 4; ++m) {
            const size_t row = m0 + ai * 128 + wr2 * 64 + m * 16 + fr;
#pragma unroll
            for (int bj = 0; bj < 2; ++bj)
#pragma unroll
              for (int n = 0; n < 2; ++n) store_bf4(QK + row * 1024 + n0 + bj * 128 + wc4 * 32 + n * 16 + fq * 4, acc[ai][bj][m][n]);
          }
      }
    } else if (sp == 10) {
      for (int it = WG; it < 1024; it += NWG) xattn_item(p, l, it, smem_all, t8);
    } else if (sp == 13) {
      for (int it = WG; it < 128 * 22; it += NWG) {
        int nt, mt; xcd_tile(it, WG, NWG, 22, mt, nt);
        const int m0 = mt * 256, n0 = nt * 256;
        f32x4 acc[2][2][4][2];
        zero_acc8p(acc);
        gemm8p(HB + (size_t)m0 * 1024, 1024, (const bf16_t*)(ws + O_WGU) + (size_t)n0 * 1024, 1024, 1024, acc, smem_all, t8);
#pragma unroll
        for (int ai = 0; ai < 2; ++ai)
#pragma unroll
          for (int m = 0; m < 4; ++m) {
            const size_t row = m0 + ai * 128 + wr2 * 64 + m * 16 + fr;
#pragma unroll
            for (int bj = 0; bj < 2; ++bj) {
              f32x4 y;
#pragma unroll
              for (int r = 0; r < 4; ++r) { const float a = acc[ai][bj][m][0][r]; y[r] = a * sigmoidf_(a) * acc[ai][bj][m][1][r]; }
              store_bf4(QK + row * DFF + nt * 128 + bj * 64 + wc4 * 16 + fq * 4, y);
            }
          }
      }
    }
    }
    if (coop && ph + 1 < ph_hi) {
      unsigned* bar = (unsigned*)(p.ws + O_BAR);
      __builtin_amdgcn_fence(__ATOMIC_RELEASE, "workgroup");
      asm volatile("s_waitcnt vmcnt(0)" ::: "memory");
      __syncthreads();
      if (threadIdx.x == 0) {
        const unsigned target = (unsigned)(ph - ph_lo + 1) * gridDim.x;
        __builtin_amdgcn_fence(__ATOMIC_RELEASE, "agent");
        __hip_atomic_fetch_add(bar, 1u, __ATOMIC_RELAXED, __HIP_MEMORY_SCOPE_AGENT);
        while (__hip_atomic_load(bar, __ATOMIC_RELAXED, __HIP_MEMORY_SCOPE_AGENT) < target) __builtin_amdgcn_s_sleep(1);
        __builtin_amdgcn_fence(__ATOMIC_ACQUIRE, "agent");
      }
      __syncthreads();
    }
#ifdef EXTRA_SYNC
    if (coop) for (int e = 0; e < EXTRA_SYNC; ++e) cg::this_grid().sync();
#endif
  }
}

extern "C" void kernel_launch(void* const* d_in, const int* in_sizes, int n_in, void* d_out, int out_size, void* d_ws,
                              size_t ws_size, hipStream_t stream) {
  Params p{};
  const float** pp = (const float**)&p;
  for (int i = 0; i < 32; ++i) pp[i] = (const float*)d_in[i];
  p.out = (float*)d_out;
  p.ws = (unsigned char*)d_ws;
  if (ws_size < O_END) return;
  static int grid = 0;
  if (!grid) {
    int dev = 0, cus = 0, per_cu = 0;
    hipGetDevice(&dev);
    hipDeviceGetAttribute(&cus, hipDeviceAttributeMultiprocessorCount, dev);
    hipOccupancyMaxActiveBlocksPerMultiprocessor(&per_cu, mega, 512, 0);
    if (per_cu < 1) per_cu = 1;
    if (per_cu > 1) per_cu = 1;
    grid = cus * per_cu;
  }
#if MK_MULTI
  for (int ph = 0; ph < NL * NPH; ++ph) hipLaunchKernelGGL(mega, dim3(grid), dim3(512), 0, stream, p, ph, ph + 1, 0);
#else
  int lo = 0, hi = NL * NPH, coop = 1;
  void* args[] = {&p, &lo, &hi, &coop};
  hipError_t e = hipLaunchCooperativeKernel((void*)mega, dim3(grid), dim3(512), args, 0, stream);
  if (e != hipSuccess) fprintf(stderr, "cooperative launch failed: %s (grid %d)\n", hipGetErrorString(e), grid);
#endif
}
```
